# Optimizing an MI355X kernel written in HIP

```python
import jax, jax.numpy as jnp
from jax import lax
import numpy as np

D_MODEL = 1024
BATCH = 2
SEQ = 16384
DEPTH = 1
DEC_BATCH = 8
DEC_SEQ = 2048
PAST_LEN = 128

N_FOURIER_GROUPS = 4
FOURIER_GROUP_DIM = D_MODEL // 8
FOURIER_WIDTH = N_FOURIER_GROUPS * FOURIER_GROUP_DIM
POOL_WINDOWS = (2, 4, 8, 16)
N_POOL_GROUPS = len(POOL_WINDOWS)
POOL_GROUP_DIM = D_MODEL // 8
POOL_WIDTH = N_POOL_GROUPS * POOL_GROUP_DIM
N_BRANCHES = 2
IN_WIDTH = FOURIER_WIDTH + POOL_WIDTH + N_BRANCHES * D_MODEL
D_FF = ((8 * D_MODEL // 3 + 255) // 256) * 256
N_ADA = 6
EPS = 1e-6

kernel_name = "fourier_pool_hybrid_encoder"


def _rmsnorm(x, g):
    xf = x.astype(jnp.float32)
    y = xf * lax.rsqrt(jnp.mean(xf * xf, axis=-1, keepdims=True) + EPS)
    return (y * g.astype(jnp.float32)).astype(x.dtype)


def _modulate(h, shift, scale):
    return h * (1 + scale[:, None, :]) + shift[:, None, :]


def _fourier_mix(u):
    b, s, _ = u.shape
    ug = u.reshape(b, s, N_FOURIER_GROUPS, FOURIER_GROUP_DIM).astype(jnp.float32)
    f = jnp.fft.fft2(ug, axes=(1, 3), norm="ortho").real
    return f.reshape(b, s, FOURIER_WIDTH).astype(u.dtype)


def _centred_mean(u, w):
    s = u.shape[1]
    left = w // 2
    right = w - 1 - left
    up = jnp.pad(u.astype(jnp.float32), ((0, 0), (left, right), (0, 0)))
    cs = jnp.pad(jnp.cumsum(up, axis=1), ((0, 0), (1, 0), (0, 0)))
    win = cs[:, w:w + s] - cs[:, :s]
    t = jnp.arange(s)
    cnt = jnp.minimum(t + right, s - 1) - jnp.maximum(t - left, 0) + 1
    return win / cnt.astype(jnp.float32)[None, :, None]


def _pool_mix(u, w_pg, pool_scale):
    b, s, _ = u.shape
    ug = u.reshape(b, s, N_POOL_GROUPS, POOL_GROUP_DIM)
    diffs = [_centred_mean(ug[:, :, i], POOL_WINDOWS[i]) - ug[:, :, i].astype(jnp.float32)
             for i in range(N_POOL_GROUPS)]
    d = jnp.stack(diffs, axis=2).astype(u.dtype)
    y = jnp.einsum("bsgc,gcd->bsgd", d, w_pg)
    return y.reshape(b, s, POOL_WIDTH) * pool_scale


def _layer(x, c, w_ada, b_ada, g_pre_mix, w_in, w_fo, w_pg, pool_scale, w_po, w_out,
           g_post_mix, g_pre_ffn, w_gate, w_up, w_down, g_post_ffn):
    ada = jnp.einsum("bd,de->be", jax.nn.silu(c), w_ada) + b_ada
    sh1, sc1, gt1, sh2, sc2, gt2 = jnp.split(ada, N_ADA, axis=-1)

    h = _modulate(_rmsnorm(x, g_pre_mix), sh1, sc1)
    proj = jnp.einsum("bsd,de->bse", h, w_in)
    u_f = proj[..., :FOURIER_WIDTH]
    u_p = proj[..., FOURIER_WIDTH:FOURIER_WIDTH + POOL_WIDTH]
    gate_logits = proj[..., FOURIER_WIDTH + POOL_WIDTH:]
    y_f = jnp.einsum("bsf,fd->bsd", _fourier_mix(u_f), w_fo)
    y_p = jnp.einsum("bsp,pd->bsd", _pool_mix(u_p, w_pg, pool_scale), w_po)
    gates = jax.nn.sigmoid(gate_logits)
    g_f = gates[..., :D_MODEL]
    g_p = gates[..., D_MODEL:]
    m = jnp.einsum("bsd,de->bse", g_f * y_f + g_p * y_p, w_out)
    x = x + gt1[:, None, :] * _rmsnorm(m, g_post_mix)

    h = _modulate(_rmsnorm(x, g_pre_ffn), sh2, sc2)
    a = jnp.einsum("bsd,df->bsf", h, w_gate)
    bup = jnp.einsum("bsd,df->bsf", h, w_up)
    z = jnp.einsum("bsf,fd->bsd", jax.nn.silu(a) * bup, w_down)
    x = x + gt2[:, None, :] * _rmsnorm(z, g_post_ffn)
    return x


def setup_inputs(seed: int = 0) -> dict:
    key = jax.random.key(seed)
    ks = jax.random.split(key, 20)
    D = D_MODEL

    def nrm(k, shape, fan_in):
        return jax.random.normal(k, shape, jnp.float32) * (fan_in ** -0.5)

    def gain(k, shape):
        return 1.0 + 0.1 * jax.random.normal(k, shape, jnp.float32)

    return {
        "x_prompt": jax.random.normal(ks[0], (BATCH, SEQ, D), jnp.float32),
        "x_sample": jax.random.normal(ks[1], (DEC_BATCH, DEC_SEQ, D), jnp.float32),
        "c_prompt": jax.random.normal(ks[2], (BATCH, D), jnp.float32),
        "c_sample": jax.random.normal(ks[3], (DEC_BATCH, D), jnp.float32),
        "w_ada": nrm(ks[4], (DEPTH, D, N_ADA * D), D),
        "b_ada": 0.01 * jax.random.normal(ks[5], (DEPTH, N_ADA * D), jnp.float32),
        "g_pre_mix": gain(ks[6], (DEPTH, D)),
        "w_in": nrm(ks[7], (DEPTH, D, IN_WIDTH), D),
        "w_fo": nrm(ks[8], (DEPTH, FOURIER_WIDTH, D), FOURIER_WIDTH),
        "w_pg": nrm(ks[9], (DEPTH, N_POOL_GROUPS, POOL_GROUP_DIM, POOL_GROUP_DIM), POOL_GROUP_DIM),
        "pool_scale": gain(ks[10], (DEPTH, POOL_WIDTH)),
        "w_po": nrm(ks[11], (DEPTH, POOL_WIDTH, D), POOL_WIDTH),
        "w_out": nrm(ks[12], (DEPTH, D, D), D),
        "g_post_mix": gain(ks[13], (DEPTH, D)),
        "g_pre_ffn": gain(ks[14], (DEPTH, D)),
        "w_gate": nrm(ks[15], (DEPTH, D, D_FF), D),
        "w_up": nrm(ks[16], (DEPTH, D, D_FF), D),
        "w_down": nrm(ks[17], (DEPTH, D_FF, D), D_FF),
        "g_post_ffn": gain(ks[18], (DEPTH, D)),
    }


def reference(x_prompt, x_sample, c_prompt, c_sample, w_ada, b_ada, g_pre_mix, w_in, w_fo,
              w_pg, pool_scale, w_po, w_out, g_post_mix, g_pre_ffn, w_gate, w_up, w_down,
              g_post_ffn):
    y_prompt = x_prompt
    y_sample = x_sample
    for l in range(DEPTH):
        params = (w_ada[l], b_ada[l], g_pre_mix[l], w_in[l], w_fo[l], w_pg[l], pool_scale[l],
                  w_po[l], w_out[l], g_post_mix[l], g_pre_ffn[l], w_gate[l], w_up[l],
                  w_down[l], g_post_ffn[l])
        y_prompt = _layer(y_prompt, c_prompt, *params)
        y_sample = _layer(y_sample, c_sample, *params)
    return (y_prompt, y_sample)
```

```cpp
#include <hip/hip_runtime.h>
#include <hip/hip_cooperative_groups.h>
#include <cstdio>
#include <cstdint>
namespace cg = cooperative_groups;

#define LAS __attribute__((address_space(3)))
typedef unsigned short bf16_t;
typedef short bf16x8 __attribute__((ext_vector_type(8)));
typedef _Float16 half8 __attribute__((ext_vector_type(8)));
typedef _Float16 half4 __attribute__((ext_vector_type(4)));
typedef _Float16 half2v __attribute__((ext_vector_type(2)));
typedef float f32x4 __attribute__((ext_vector_type(4)));
typedef unsigned u32x4 __attribute__((ext_vector_type(4)));
typedef unsigned u32x2 __attribute__((ext_vector_type(2)));

constexpr int D = 1024, TP = 2 * 16384, TS = 8 * 2048, T = TP + TS;
constexpr int NB = 10;
constexpr int FF = 2816, NADA = 6 * D;
constexpr float EPS = 1e-6f;
constexpr int NWAVES = 8, NTHR = 512;

constexpr size_t MiB = 1u << 20;
constexpr size_t WS_ADA = 0;
constexpr size_t WS_BAR = 512 * 1024;
constexpr size_t WS_XCTR = 512 * 1024 + 16384;
constexpr size_t WS_MEMSET_BYTES = 16384 + 2 * 192 * 64;
constexpr size_t WS_ROOT = 768 * 1024;
constexpr size_t WS_FC = 1 * MiB;
constexpr int FT_LD = 136, FT_BYTES = 128 * FT_LD * 2;
constexpr size_t WS_W1T = 2 * MiB;
constexpr size_t WS_W2T = 8 * MiB;
constexpr size_t WS_W3T = 10 * MiB;
constexpr size_t WS_W4T = 12 * MiB;
constexpr size_t WS_W5T = 23 * MiB;
constexpr size_t WS_H = 32 * MiB;
constexpr size_t WS_GATES = 128 * MiB;
constexpr size_t WS_UF = 320 * MiB;
constexpr size_t WS_UP = 368 * MiB;
constexpr size_t WS_A2 = 416 * MiB;
constexpr size_t WS_MBUF = 320 * MiB;
constexpr size_t WS_SBUF = 128 * MiB;
constexpr size_t WS_ZBUF = 416 * MiB;
constexpr size_t WS_SS1 = 128 * MiB;
constexpr size_t WS_SS2 = 32 * MiB;
constexpr size_t WS_SSX = 28 * MiB + 512 * 1024;
constexpr size_t WS_X1B = 416 * MiB;
constexpr size_t WS_END = 512 * MiB;

constexpr int LDS_BYTES = 147456;

typedef __bf16 bf16x2_t __attribute__((ext_vector_type(2)));
typedef float f32x2_t __attribute__((ext_vector_type(2)));
__device__ __forceinline__ unsigned cvt_pk_bf16(float lo, float hi) { const f32x2_t v = {lo, hi}; const bf16x2_t b = __builtin_convertvector(v, bf16x2_t); return __builtin_bit_cast(unsigned, b); }
__device__ __forceinline__ unsigned pk_f16(float lo, float hi) { half2v h = {(_Float16)lo, (_Float16)hi}; return __builtin_bit_cast(unsigned, h); }
__device__ __forceinline__ float bf_lo(unsigned w) { return __builtin_bit_cast(float, w << 16); }
__device__ __forceinline__ float bf_hi(unsigned w) { return __builtin_bit_cast(float, w & 0xffff0000u); }
__device__ __forceinline__ float sigmoid_f(float x) { return __builtin_amdgcn_rcpf(1.f + __expf(-x)); }
__device__ __forceinline__ float wave_sum(float v) {
#pragma unroll
    for (int o = 1; o < 64; o <<= 1) v += __shfl_xor(v, o);
    return v;
}
__device__ __forceinline__ void tok_info(int t, int& r, int& tb, int& S) {
    if (t < TP) { r = t >> 14; tb = r << 14; S = 16384; }
    else { const int j = (t - TP) >> 11; r = 2 + j; tb = TP + (j << 11); S = 2048; }
}

namespace pg8 {
constexpr int BM = 256, BK = 64, HALF = 128, HTB = HALF * BK * 2, NXCD = 8, WGM = 8;
__host__ __device__ __forceinline__ int lds_byte(int r, int c) { const int st = (r >> 4) * 2 + (c >> 5), rr = r & 15, cc = c & 31, ob = rr * 64 + cc * 2; return st * 1024 + (ob ^ (((ob >> 9) & 1) << 5)); }
__host__ __device__ __forceinline__ void stage_rc(int b, int& R, int& C) { const int st = b / 1024, sb = b % 1024, swz = sb ^ (((sb >> 9) & 1) << 5); R = (st >> 1) * 16 + swz / 64; C = (st & 1) * 32 + (swz % 64) / 2; }
__host__ __device__ __forceinline__ int perm32(int rho) { const int n = rho >> 4, i = rho & 15; return 8 * (i >> 2) + 4 * n + (i & 3); }

struct Unit { int pm, pn, part; };
struct Gemm { const bf16_t* A; const bf16_t* Bt; int M, N, K, lda, ldb, poffA, poffB; };

struct StaticOrder {
    int nM, nN, nwg, G, c;
    __device__ void init(int M, int N, int G_, int c_) { nM = M / BM; nN = N / BM; nwg = nM * nN; G = G_; c = c_; }
    __device__ bool next(int i, Unit& u) const {
        const long L = (long)i * G + c; if (L >= nwg) return false;
        int wgid = (int)L; { const int q = nwg / NXCD, r = nwg % NXCD, xcd = wgid % NXCD, off = wgid / NXCD; wgid = (xcd < r ? xcd * (q + 1) : r * (q + 1) + (xcd - r) * q) + off; }
        const int nig = WGM * nN, gid = wgid / nig, fm = gid * WGM, gsz = (nM - fm) < WGM ? (nM - fm) : WGM;
        u.pm = fm + ((wgid % nig) % gsz); u.pn = (wgid % nig) / gsz; u.part = 0; return true;
    }
};
struct TwoPartOrder {
    StaticOrder S;
    __device__ void init(int M, int N, int G_, int c_) { S.init(M, N, G_, c_); }
    __device__ bool next(int i, Unit& u) const { if (!S.next(i >> 1, u)) return false; u.part = i & 1; return true; }
};

template <class Epi, class Sched>
__device__ __forceinline__ void gemm_phase(LAS unsigned char* lds, const Gemm g, const Sched& S, const Epi& E) {
    int tid = threadIdx.x; asm volatile("" : "+v"(tid));
    const int wid = __builtin_amdgcn_readfirstlane(tid >> 6), lane = tid & 63, wr = wid >> 2, wc = wid & 3, fr = lane & 15, fq = lane >> 4;
    const int K = g.K, nt = K / BK;
    unsigned voffA[2], voffB[2];
#pragma unroll
    for (int i = 0; i < 2; ++i) { int R, C; stage_rc(tid * 16 + i * 8192, R, C); const int Rb = (R & ~31) + perm32(R & 31);
        voffA[i] = (unsigned)(R * g.lda + C) * 2u; voffB[i] = (unsigned)(Rb * g.ldb + C) * 2u; }
    const size_t kstep = (size_t)(BK * 2);
    const size_t hstepA = (size_t)HALF * g.lda * 2, hstepB = (size_t)HALF * g.ldb * 2;
    const size_t tstepA = 2 * hstepA, tstepB = 2 * hstepB;
    const unsigned ldsw = (unsigned)wid * 1024u;
    const int aoff = lds_byte(wr * 64 + fr, fq * 8), boff = lds_byte(wc * 32 + fr, fq * 8);
#define PG8_SA(b, h) (((b) * 2 + (h)) * HTB)
#define PG8_SB(b, h) ((4 + (b) * 2 + (h)) * HTB)
#define PG8_STAGE(bufoff, gbase, voff) do { _Pragma("unroll") for (int _i = 0; _i < 2; ++_i) \
        __builtin_amdgcn_global_load_lds((const unsigned*)((const char*)(gbase) + (voff)[_i]), (LAS unsigned*)(lds + (bufoff) + ldsw + _i * 8192), 16, 0, 0); } while (0)
#define PG8_LDA(dst, b, h) do { _Pragma("unroll") for (int m = 0; m < 4; ++m) _Pragma("unroll") for (int k = 0; k < 2; ++k) dst[m][k] = *(const LAS bf16x8*)(lds + PG8_SA(b, h) + aoff + m * 2048 + k * 1024); } while (0)
#define PG8_LDB(dst, b, h) do { _Pragma("unroll") for (int n = 0; n < 2; ++n) _Pragma("unroll") for (int k = 0; k < 2; ++k) dst[n][k] = *(const LAS bf16x8*)(lds + PG8_SB(b, h) + boff + n * 2048 + k * 1024); } while (0)
#define PG8_MMA(ai, bj, At, Bt) do { __builtin_amdgcn_s_setprio(1); _Pragma("unroll") for (int m = 0; m < 4; ++m) _Pragma("unroll") for (int n = 0; n < 2; ++n) _Pragma("unroll") for (int k = 0; k < 2; ++k) \
        acc[ai][bj][m][n] = __builtin_amdgcn_mfma_f32_16x16x32_bf16(Bt[n][k], At[m][k], acc[ai][bj][m][n], 0, 0, 0); __builtin_amdgcn_s_setprio(0); } while (0)
#define PG8_WAIT_V(n) asm volatile("s_waitcnt vmcnt(" #n ")" ::: "memory")
#define PG8_WAIT_L(n) asm volatile("s_waitcnt lgkmcnt(" #n ")" ::: "memory")
#define PG8_BAR __builtin_amdgcn_s_barrier()
#define PG8_SCHED __builtin_amdgcn_sched_barrier(0)
    Unit cur, nxt; int ui = 0;
    if (!S.next(0, cur)) return;
    f32x4 acc[2][2][4][2];
#pragma unroll
    for (int a = 0; a < 2; ++a)
#pragma unroll
        for (int b = 0; b < 2; ++b)
#pragma unroll
            for (int m = 0; m < 4; ++m)
#pragma unroll
                for (int n = 0; n < 2; ++n) acc[a][b][m][n] = (f32x4){0.f, 0.f, 0.f, 0.f};
    bf16x8 At[4][2], B0[2][2], B1[2][2];
    const char* cA = (const char*)g.A + (size_t)cur.pm * tstepA + (size_t)cur.part * g.poffA; const char* cB = (const char*)g.Bt + (size_t)cur.pn * tstepB + (size_t)cur.part * g.poffB;
    PG8_STAGE(PG8_SB(0, 0), cB, voffB); PG8_STAGE(PG8_SB(0, 1), cB + hstepB, voffB); PG8_STAGE(PG8_SA(0, 0), cA, voffA); PG8_STAGE(PG8_SA(0, 1), cA + hstepA, voffA);
    if (wr == 1) PG8_BAR;
    PG8_WAIT_V(2); PG8_BAR;
    PG8_STAGE(PG8_SB(1, 0), cB + kstep, voffB); PG8_STAGE(PG8_SA(1, 0), cA + kstep, voffA); PG8_STAGE(PG8_SB(1, 1), cB + hstepB + kstep, voffB);
    PG8_WAIT_V(6); PG8_BAR;
    for (;;) {
        const bool has_next = S.next(ui + 1, nxt);
        const char* nA = has_next ? (const char*)g.A + (size_t)nxt.pm * tstepA + (size_t)nxt.part * g.poffA : cA; const char* nB = has_next ? (const char*)g.Bt + (size_t)nxt.pn * tstepB + (size_t)nxt.part * g.poffB : cB;
        for (int t = 0; t < nt; t += 2) {
            const bool last = (t == nt - 2);
            const char* a1 = cA + (size_t)(t + 1) * kstep;
            const char* a2 = last ? nA : cA + (size_t)(t + 2) * kstep; const char* b2 = last ? nB : cB + (size_t)(t + 2) * kstep;
            const char* a3 = a2 + kstep; const char* b3 = b2 + kstep;
            PG8_LDB(B0, 0, 0); PG8_LDB(B1, 0, 1); PG8_SCHED; PG8_LDA(At, 0, 0); PG8_STAGE(PG8_SA(1, 1), a1 + hstepA, voffA);
            PG8_WAIT_V(8); PG8_WAIT_L(0); PG8_BAR; PG8_MMA(0, 0, At, B0); PG8_MMA(0, 1, At, B1); PG8_BAR; PG8_SCHED;
            PG8_LDA(At, 0, 1); PG8_STAGE(PG8_SB(0, 0), b2, voffB); PG8_STAGE(PG8_SB(0, 1), b2 + hstepB, voffB); PG8_STAGE(PG8_SA(0, 0), a2, voffA);
            PG8_WAIT_V(8); PG8_WAIT_L(0); PG8_BAR; PG8_MMA(1, 0, At, B0); PG8_MMA(1, 1, At, B1); PG8_BAR; PG8_SCHED;
            PG8_LDB(B0, 1, 0); PG8_LDB(B1, 1, 1); PG8_SCHED; PG8_LDA(At, 1, 0); PG8_STAGE(PG8_SA(0, 1), a2 + hstepA, voffA);
            PG8_WAIT_V(8); PG8_WAIT_L(0); PG8_BAR; PG8_MMA(0, 0, At, B0); PG8_MMA(0, 1, At, B1); PG8_BAR; PG8_SCHED;
            PG8_LDA(At, 1, 1); PG8_STAGE(PG8_SB(1, 0), b3, voffB); PG8_STAGE(PG8_SB(1, 1), b3 + hstepB, voffB); PG8_STAGE(PG8_SA(1, 0), a3, voffA);
            PG8_WAIT_V(8); PG8_WAIT_L(0); PG8_BAR; PG8_MMA(1, 0, At, B0); PG8_MMA(1, 1, At, B1); PG8_BAR; PG8_SCHED;
        }
        if (wr == 0) PG8_BAR;
        E(acc, cur, wr, wc, fr, fq);
        if (!has_next) break;
        if (!(Epi::TWO_PART && cur.part == 0)) {
#pragma unroll
        for (int a = 0; a < 2; ++a)
#pragma unroll
            for (int b = 0; b < 2; ++b)
#pragma unroll
                for (int m = 0; m < 4; ++m)
#pragma unroll
                    for (int n = 0; n < 2; ++n) acc[a][b][m][n] = (f32x4){0.f, 0.f, 0.f, 0.f};
        }
        cur = nxt; cA = nA; cB = nB; ++ui;
        if (wr == 1) PG8_BAR;
    }
    PG8_WAIT_V(0);
    PG8_BAR;
#undef PG8_SA
#undef PG8_SB
#undef PG8_STAGE
#undef PG8_LDA
#undef PG8_LDB
#undef PG8_MMA
#undef PG8_WAIT_V
#undef PG8_WAIT_L
#undef PG8_BAR
#undef PG8_SCHED
}

typedef f32x4 Acc[2][2][4][2];

struct EpiG1 {
    static constexpr bool TWO_PART = false;
    _Float16* UF; bf16_t* UP; bf16_t* GT;
    __device__ __forceinline__ void operator()(const Acc& acc, const Unit& u, int wr, int wc, int fr, int fq) const {
        const int row0 = u.pm * BM + wr * 64 + fr, c0 = wc * 32 + 8 * fq, pn = u.pn;
#pragma unroll
        for (int ai = 0; ai < 2; ++ai)
#pragma unroll
            for (int m = 0; m < 4; ++m) { const size_t row = (size_t)(row0 + ai * HALF + m * 16);
#pragma unroll
                for (int bj = 0; bj < 2; ++bj) { const f32x4 v0 = acc[ai][bj][m][0], v1 = acc[ai][bj][m][1]; const int c = c0 + bj * HALF; u32x4 w;
                    if (pn < 2) { w.x = pk_f16(v0[0], v0[1]); w.y = pk_f16(v0[2], v0[3]); w.z = pk_f16(v1[0], v1[1]); w.w = pk_f16(v1[2], v1[3]);
                        *(u32x4*)(UF + row * 512 + pn * 256 + c) = w; }
                    else if (pn < 4) { w.x = cvt_pk_bf16(v0[0], v0[1]); w.y = cvt_pk_bf16(v0[2], v0[3]); w.z = cvt_pk_bf16(v1[0], v1[1]); w.w = cvt_pk_bf16(v1[2], v1[3]);
                        *(u32x4*)(UP + row * 512 + (pn - 2) * 256 + c) = w; }
                    else if (bj == 0) {
                        const f32x4 q0 = acc[ai][1][m][0], q1 = acc[ai][1][m][1]; float rt[8], sp[8];
#pragma unroll
                        for (int e = 0; e < 4; ++e) { const float ef0 = __expf(-v0[e]), ep0 = fminf(__expf(-q0[e]), 1e30f), ef1 = __expf(-v1[e]), ep1 = fminf(__expf(-q1[e]), 1e30f);
                            sp[e] = __builtin_amdgcn_rcpf(1.f + ep0); rt[e] = (1.f + ep0) * __builtin_amdgcn_rcpf(1.f + ef0); sp[4 + e] = __builtin_amdgcn_rcpf(1.f + ep1); rt[4 + e] = (1.f + ep1) * __builtin_amdgcn_rcpf(1.f + ef1); }
                        const int ch = (pn - 4) * 128 + c0;
                        w.x = cvt_pk_bf16(rt[0], rt[1]); w.y = cvt_pk_bf16(rt[2], rt[3]); w.z = cvt_pk_bf16(rt[4], rt[5]); w.w = cvt_pk_bf16(rt[6], rt[7]);
                        __builtin_nontemporal_store(w, (u32x4*)(GT + row * 2048 + ch));
                        w.x = cvt_pk_bf16(sp[0], sp[1]); w.y = cvt_pk_bf16(sp[2], sp[3]); w.z = cvt_pk_bf16(sp[4], sp[5]); w.w = cvt_pk_bf16(sp[6], sp[7]);
                        __builtin_nontemporal_store(w, (u32x4*)(GT + row * 2048 + 1024 + ch)); } } }
    }
};
struct EpiMix2 {
    static constexpr bool TWO_PART = true;
    bf16_t* MIX; const bf16_t* GT;
    __device__ __forceinline__ void operator()(Acc& acc, const Unit& u, int wr, int wc, int fr, int fq) const {
        const int row0 = u.pm * BM + wr * 64 + fr, c0 = u.pn * BM + wc * 32 + 8 * fq;
#pragma unroll
        for (int ai = 0; ai < 2; ++ai)
#pragma unroll
            for (int m = 0; m < 4; ++m) { const size_t row = (size_t)(row0 + ai * HALF + m * 16);
#pragma unroll
                for (int bj = 0; bj < 2; ++bj) { const int c = c0 + bj * HALF;
                    const u32x4 gq = __builtin_nontemporal_load((const u32x4*)(GT + row * 2048 + (u.part == 0 ? 0 : 1024) + c));
                    const float p[8] = {bf_lo(gq.x), bf_hi(gq.x), bf_lo(gq.y), bf_hi(gq.y), bf_lo(gq.z), bf_hi(gq.z), bf_lo(gq.w), bf_hi(gq.w)};
                    if (u.part == 0) {
#pragma unroll
                        for (int e = 0; e < 4; ++e) { acc[ai][bj][m][0][e] *= p[e]; acc[ai][bj][m][1][e] *= p[4 + e]; }
                    } else {
                        const f32x4 v0 = acc[ai][bj][m][0], v1 = acc[ai][bj][m][1];
                        u32x4 w; w.x = cvt_pk_bf16(v0[0] * p[0], v0[1] * p[1]); w.y = cvt_pk_bf16(v0[2] * p[2], v0[3] * p[3]); w.z = cvt_pk_bf16(v1[0] * p[4], v1[1] * p[5]); w.w = cvt_pk_bf16(v1[2] * p[6], v1[3] * p[7]);
                        *(u32x4*)(MIX + row * 1024 + c) = w; } } }
    }
};
struct EpiRowSS {
    static constexpr bool TWO_PART = false;
    bf16_t* O; float* ss;
    __device__ __forceinline__ void operator()(const Acc& acc, const Unit& u, int wr, int wc, int fr, int fq) const {
        const int row0 = u.pm * BM + wr * 64 + fr, c0 = u.pn * BM + wc * 32 + 8 * fq;
#pragma unroll
        for (int ai = 0; ai < 2; ++ai)
#pragma unroll
            for (int m = 0; m < 4; ++m) { const size_t row = (size_t)(row0 + ai * HALF + m * 16); float p = 0.f;
#pragma unroll
                for (int bj = 0; bj < 2; ++bj) { const f32x4 v0 = acc[ai][bj][m][0], v1 = acc[ai][bj][m][1]; const int c = c0 + bj * HALF;
                    p += (v0[0] * v0[0] + v0[1] * v0[1]) + (v0[2] * v0[2] + v0[3] * v0[3]) + (v1[0] * v1[0] + v1[1] * v1[1]) + (v1[2] * v1[2] + v1[3] * v1[3]);
                    u32x4 w; w.x = cvt_pk_bf16(v0[0], v0[1]); w.y = cvt_pk_bf16(v0[2], v0[3]); w.z = cvt_pk_bf16(v1[0], v1[1]); w.w = cvt_pk_bf16(v1[2], v1[3]);
                    *(u32x4*)(O + row * 1024 + c) = w; }
                p += __shfl_xor(p, 16); p += __shfl_xor(p, 32);
                if (fq == 0) ss[row * 16 + u.pn * 4 + wc] = p; }
    }
};
struct EpiFinal {
    static constexpr bool TWO_PART = false;
    float* out; const bf16_t* x1b; const float* ada; const float* gpost; float* ssx; unsigned* ctr; LAS float* xl;
    __device__ __forceinline__ void operator()(const Acc& acc, const Unit& u, int wr, int wc, int fr, int fq) const {
        const int tid = threadIdx.x, lrow0 = wr * 64 + fr;
#pragma unroll
        for (int ai = 0; ai < 2; ++ai)
#pragma unroll
            for (int m = 0; m < 4; ++m) { float p = 0.f;
#pragma unroll
                for (int bj = 0; bj < 2; ++bj) { const f32x4 v0 = acc[ai][bj][m][0], v1 = acc[ai][bj][m][1];
                    p += (v0[0] * v0[0] + v0[1] * v0[1]) + (v0[2] * v0[2] + v0[3] * v0[3]) + (v1[0] * v1[0] + v1[1] * v1[1]) + (v1[2] * v1[2] + v1[3] * v1[3]); }
                p += __shfl_xor(p, 16); p += __shfl_xor(p, 32);
                if (fq == 0) xl[wc * 256 + ai * HALF + m * 16 + lrow0] = p; }
        __syncthreads();
        float* slot = ssx + ((size_t)u.pm * 4) * 256;
        if (tid < 256) { const float sv = (xl[tid] + xl[256 + tid]) + (xl[512 + tid] + xl[768 + tid]);
            __hip_atomic_store((unsigned*)(slot + u.pn * 256 + tid), __builtin_bit_cast(unsigned, sv), __ATOMIC_RELAXED, __HIP_MEMORY_SCOPE_AGENT); }
        asm volatile("s_waitcnt vmcnt(0)" ::: "memory");
        __syncthreads();
        if (tid == 0) { unsigned* c = ctr + u.pm * 16;
            __hip_atomic_fetch_add(c, 1u, __ATOMIC_RELAXED, __HIP_MEMORY_SCOPE_AGENT);
            unsigned sp = 0; while (__hip_atomic_load(c, __ATOMIC_RELAXED, __HIP_MEMORY_SCOPE_AGENT) < 4u) { __builtin_amdgcn_s_sleep(1); if (++sp > (1u << 22)) break; } }
        __syncthreads();
        if (tid < 256) { float sv = 0.f;
#pragma unroll
            for (int pn = 0; pn < 4; ++pn) sv += __builtin_bit_cast(float, __hip_atomic_load((unsigned*)(slot + pn * 256 + tid), __ATOMIC_RELAXED, __HIP_MEMORY_SCOPE_AGENT));
            xl[1024 + tid] = rsqrtf(sv * (1.f / D) + EPS); }
        __syncthreads();
        int r, tb, S; tok_info(u.pm * BM, r, tb, S);
        const int c0 = u.pn * BM + wc * 32 + 8 * fq;
        float gg[2][8];
#pragma unroll
        for (int bj = 0; bj < 2; ++bj) { const float* gt = ada + (size_t)r * NADA + 5 * D + c0 + bj * HALF; const float* gp = gpost + c0 + bj * HALF;
            const f32x4 a0 = *(const f32x4*)gt, a1 = *(const f32x4*)(gt + 4), b0 = *(const f32x4*)gp, b1 = *(const f32x4*)(gp + 4);
#pragma unroll
            for (int e = 0; e < 4; ++e) { gg[bj][e] = a0[e] * b0[e]; gg[bj][4 + e] = a1[e] * b1[e]; } }
#pragma unroll
        for (int ai = 0; ai < 2; ++ai)
#pragma unroll
            for (int m = 0; m < 4; ++m) { const int lr = ai * HALF + m * 16 + lrow0; const float rs = xl[1024 + lr]; float* orow = out + (size_t)(u.pm * BM + lr) * D + c0;
#pragma unroll
                for (int bj = 0; bj < 2; ++bj) { const u32x4 xb = __builtin_nontemporal_load((const u32x4*)(x1b + (size_t)(u.pm * BM + lr) * D + c0 + bj * HALF));
                    f32x4 x0 = {bf_lo(xb.x), bf_hi(xb.x), bf_lo(xb.y), bf_hi(xb.y)}, x1 = {bf_lo(xb.z), bf_hi(xb.z), bf_lo(xb.w), bf_hi(xb.w)}; const f32x4 v0 = acc[ai][bj][m][0], v1 = acc[ai][bj][m][1];
#pragma unroll
                    for (int e = 0; e < 4; ++e) { x0[e] += gg[bj][e] * (v0[e] * rs); x1[e] += gg[bj][4 + e] * (v1[e] * rs); }
                    __builtin_nontemporal_store(x0, (f32x4*)(orow + bj * HALF)); __builtin_nontemporal_store(x1, (f32x4*)(orow + bj * HALF + 4)); } }
    }
};
struct EpiSwiGLU {
    static constexpr bool TWO_PART = false;
    bf16_t* SB;
    __device__ __forceinline__ void operator()(const Acc& acc, const Unit& u, int wr, int wc, int fr, int fq) const {
        const int row0 = u.pm * BM + wr * 64 + fr, c0 = u.pn * HALF + wc * 32 + 8 * fq;
#pragma unroll
        for (int ai = 0; ai < 2; ++ai)
#pragma unroll
            for (int m = 0; m < 4; ++m) { const size_t row = (size_t)(row0 + ai * HALF + m * 16);
                const f32x4 a0 = acc[ai][0][m][0], a1 = acc[ai][0][m][1], b0 = acc[ai][1][m][0], b1 = acc[ai][1][m][1];
                float o[8];
#pragma unroll
                for (int i = 0; i < 4; ++i) { o[i] = a0[i] * sigmoid_f(a0[i]) * b0[i]; o[4 + i] = a1[i] * sigmoid_f(a1[i]) * b1[i]; }
                u32x4 w; w.x = cvt_pk_bf16(o[0], o[1]); w.y = cvt_pk_bf16(o[2], o[3]); w.z = cvt_pk_bf16(o[4], o[5]); w.w = cvt_pk_bf16(o[6], o[7]);
                __builtin_nontemporal_store(w, (u32x4*)(SB + row * FF + c0)); }
    }
};
}

struct Args { const float* in[19]; float* out; unsigned char* ws; };

template <class Src4>
__device__ __forceinline__ void wave_transpose(Src4 src4, bf16_t* out, int ldo, int k0, int n0, int ocol0, int orow0, LAS float* scr, int lane) {
    f32x4 v[8];
#pragma unroll
    for (int i = 0; i < 8; ++i) v[i] = src4(k0 + 8 * i + (lane >> 3), n0 + 4 * (lane & 7));
#pragma unroll
    for (int i = 0; i < 8; ++i) { LAS float* d = scr + (8 * i + (lane >> 3)) * 33 + 4 * (lane & 7); d[0] = v[i].x; d[1] = v[i].y; d[2] = v[i].z; d[3] = v[i].w; }
    asm volatile("s_waitcnt lgkmcnt(0)" ::: "memory");
    const int c = lane & 7;
#pragma unroll
    for (int j = 0; j < 4; ++j) { const int n = (lane >> 3) + 8 * j; const LAS float* sp = scr + (8 * c) * 33 + n;
        u32x4 o; o.x = cvt_pk_bf16(sp[0 * 33], sp[1 * 33]); o.y = cvt_pk_bf16(sp[2 * 33], sp[3 * 33]); o.z = cvt_pk_bf16(sp[4 * 33], sp[5 * 33]); o.w = cvt_pk_bf16(sp[6 * 33], sp[7 * 33]);
        *(u32x4*)(out + (size_t)(orow0 + n) * ldo + ocol0 + 8 * c) = o; }
    asm volatile("s_waitcnt lgkmcnt(0)" ::: "memory");
}

__device__ __forceinline__ void weight_item(const Args& a, int it, LAS float* scr, int lane) {
    unsigned char* ws = a.ws;
    constexpr int I_W1 = 16 * 96, I_W2A = 8 * 32, I_W3 = 16 * 32, I_W4 = 16 * 176;
    int r = it;
    if (r < I_W1) { const float* W = a.in[7]; const int kb = r / 96, nb = r % 96, n0 = nb * 32;
        const int src0 = n0 < 1024 ? n0 : 1024 + (((n0 - 1024) >> 7) & 1) * 1024 + ((n0 - 1024) >> 8) * 128 + (n0 & 127);
        wave_transpose([=](int k, int n) { return __builtin_nontemporal_load((const f32x4*)(W + (size_t)k * 3072 + n)); }, (bf16_t*)(ws + WS_W1T), 1024, kb * 64, src0, kb * 64, n0, scr, lane); return; }
    r -= I_W1;
    if (r < I_W2A) { const float* W = a.in[8]; const int kb = r >> 5, nb = r & 31;
        wave_transpose([=](int k, int n) { return __builtin_nontemporal_load((const f32x4*)(W + (size_t)k * 1024 + n)); }, (bf16_t*)(ws + WS_W2T), 1024, kb * 64, nb * 32, kb * 64, nb * 32, scr, lane); return; }
    r -= I_W2A;
    if (r < I_W3) { const float* W = a.in[12]; const int kb = r >> 5, nb = r & 31;
        wave_transpose([=](int k, int n) { return __builtin_nontemporal_load((const f32x4*)(W + (size_t)k * 1024 + n)); }, (bf16_t*)(ws + WS_W3T), 1024, kb * 64, nb * 32, kb * 64, nb * 32, scr, lane); return; }
    r -= I_W3;
    if (r < I_W4) { const int kb = r / 176, nb = r % 176; const int n0 = nb * 32;
        const int j = n0 >> 8, bj = (n0 >> 7) & 1, cbase = j * 128 + (n0 & 127); const float* W = bj ? a.in[16] : a.in[15];
        wave_transpose([=](int k, int n) { return __builtin_nontemporal_load((const f32x4*)(W + (size_t)k * FF + n)); }, (bf16_t*)(ws + WS_W4T), 1024, kb * 64, cbase, kb * 64, n0, scr, lane); return; }
    r -= I_W4;
    { const float* W = a.in[17]; const int kb = r >> 5, nb = r & 31;
        wave_transpose([=](int k, int n) { return __builtin_nontemporal_load((const f32x4*)(W + (size_t)k * 1024 + n)); }, (bf16_t*)(ws + WS_W5T), FF, kb * 64, nb * 32, kb * 64, nb * 32, scr, lane); }
}
constexpr int N_WEIGHT_ITEMS = 16 * 96 + 8 * 32 + 16 * 32 + 16 * 176 + 44 * 32;

__device__ __forceinline__ void phase_prep(const Args& a, LAS unsigned char* lds, int G) {
    unsigned char* ws = a.ws;
    const int tid = threadIdx.x, lane = tid & 63, wave = tid >> 6;
    {
        const int gt = blockIdx.x * NTHR + tid, NG = G * NTHR;
        float2* ROOT = (float2*)(ws + WS_ROOT);
        for (int j = gt; j < 16384; j += NG) { float s, c; sincospif((float)j * (1.f / 8192.f), &s, &c); ROOT[j] = make_float2(c, s); }
        _Float16* FC = (_Float16*)(ws + WS_FC); _Float16* FS = FC + 128 * FT_LD;
        for (int j = gt; j < 128 * FT_LD; j += NG) { const int n = j / FT_LD, k = j % FT_LD; float s = 0.f, c = 0.f;
            if (k < 128) { sincospif((float)((n * k) & 127) * (1.f / 64.f), &s, &c); s *= 0.08838834764831845f; c *= 0.08838834764831845f; }
            FC[j] = (_Float16)c; FS[j] = (_Float16)s; }
    }
    LAS float* scr = (LAS float*)lds;
    constexpr int I_ADA = 192;
    for (int it = blockIdx.x; it < I_ADA; it += G) {
        const int e0 = it * 32; const float* cp = a.in[2]; const float* cs = a.in[3]; const float* wada = a.in[4]; const float* bada = a.in[5];
        LAS float* sc = scr;
        LAS float* red = scr + NB * 1024;
        for (int j = tid; j < NB * 1024; j += NTHR) { const float v = (j < 2048) ? cp[j] : cs[j - 2048]; sc[j] = v / (1.f + expf(-v)); }
        __syncthreads();
        const int col = tid & 31, dg = tid >> 5; float accv[NB];
#pragma unroll
        for (int q = 0; q < NB; ++q) accv[q] = 0.f;
        for (int d0 = dg * 64; d0 < dg * 64 + 64; d0 += 16) { float wv[16];
#pragma unroll
            for (int u = 0; u < 16; ++u) wv[u] = __builtin_nontemporal_load(wada + (size_t)(d0 + u) * NADA + e0 + col);
#pragma unroll
            for (int u = 0; u < 16; ++u)
#pragma unroll
                for (int q = 0; q < NB; ++q) accv[q] += sc[q * 1024 + d0 + u] * wv[u]; }
#pragma unroll
        for (int q = 0; q < NB; ++q) red[(dg * NB + q) * 32 + col] = accv[q];
        __syncthreads();
        if (tid < NB * 32) { const int q = tid >> 5, cc = tid & 31; float s = bada[e0 + cc];
            for (int k = 0; k < 16; ++k) s += red[(k * NB + q) * 32 + cc];
            ((float*)(ws + WS_ADA))[q * NADA + e0 + cc] = s; }
        __syncthreads();
    }
    __syncthreads();
    LAS float* wscr = scr + wave * (64 * 33);
    const int gw = (int)blockIdx.x * NWAVES + wave, NW = G * NWAVES;
    for (int r = gw; r < 2048; r += NW) {
        const int k0 = (r >> 5) * 8, n0 = (r & 31) * 32, k = k0 + (lane >> 3), n = n0 + 4 * (lane & 7), gb = k & ~127;
        const float* pg = a.in[9] + (size_t)k * 128; const float* ps = a.in[10] + gb; const float* wpo = a.in[11] + (size_t)gb * 1024 + n;
        f32x4 s4 = {0.f, 0.f, 0.f, 0.f};
#pragma unroll 8
        for (int d = 0; d < 128; ++d) { const float c = pg[d] * ps[d]; const f32x4 wv = *(const f32x4*)(wpo + (size_t)d * 1024); s4 += wv * c; }
        LAS float* dd = wscr + (lane >> 3) * 33 + 4 * (lane & 7); dd[0] = s4.x; dd[1] = s4.y; dd[2] = s4.z; dd[3] = s4.w;
        asm volatile("s_waitcnt lgkmcnt(0)" ::: "memory");
        if (lane < 32) { const LAS float* sp = wscr + lane;
            u32x4 o; o.x = cvt_pk_bf16(sp[0 * 33], sp[1 * 33]); o.y = cvt_pk_bf16(sp[2 * 33], sp[3 * 33]); o.z = cvt_pk_bf16(sp[4 * 33], sp[5 * 33]); o.w = cvt_pk_bf16(sp[6 * 33], sp[7 * 33]);
            *(u32x4*)((bf16_t*)(ws + WS_W2T) + (size_t)(n0 + lane) * 1024 + 512 + k0) = o; }
        asm volatile("s_waitcnt lgkmcnt(0)" ::: "memory");
    }
    if (G == 256) {
        constexpr int NEXTRA = 2048;
        if (blockIdx.x >= I_ADA) for (int it = ((int)blockIdx.x - I_ADA) * NWAVES + wave; it < NEXTRA; it += 64 * NWAVES) weight_item(a, it, wscr, lane);
        for (int it = NEXTRA + gw; it < N_WEIGHT_ITEMS; it += NW) weight_item(a, it, wscr, lane);
    } else {
        for (int it = gw; it < N_WEIGHT_ITEMS; it += NW) weight_item(a, it, wscr, lane);
    }
}

__device__ __forceinline__ const float* xrow_ptr(const Args& a, int t) { return t < TP ? a.in[0] + (size_t)t * D : a.in[1] + (size_t)(t - TP) * D; }

template <int R>
__device__ __forceinline__ void phase_norm1(const Args& a, int G) {
    const int lane = threadIdx.x & 63, wave = threadIdx.x >> 6, gw = blockIdx.x * NWAVES + wave, NW = G * NWAVES;
    const float* ada = (const float*)(a.ws + WS_ADA); bf16_t* H = (bf16_t*)(a.ws + WS_H); const float* gpre = a.in[6];
    f32x4 gp[4];
#pragma unroll
    for (int j = 0; j < 4; ++j) gp[j] = ((const f32x4*)gpre + lane)[64 * j];
    for (int t0 = gw; t0 < T; t0 += R * NW) {
        f32x4 v[R][4], sc[R][4], sh[R][4];
#pragma unroll
        for (int k = 0; k < R; ++k) { const int t = t0 + k * NW; if (t < T) { int r, tb, S; tok_info(t, r, tb, S);
            const f32x4* xr = (const f32x4*)xrow_ptr(a, t) + lane; const f32x4* shp = (const f32x4*)(ada + (size_t)r * NADA) + lane; const f32x4* scp = (const f32x4*)(ada + (size_t)r * NADA + D) + lane;
#pragma unroll
            for (int j = 0; j < 4; ++j) { v[k][j] = __builtin_nontemporal_load(xr + 64 * j); sc[k][j] = scp[64 * j]; sh[k][j] = shp[64 * j]; } } }
#pragma unroll
        for (int k = 0; k < R; ++k) { const int t = t0 + k * NW; if (t < T) { float s = 0.f;
#pragma unroll
            for (int j = 0; j < 4; ++j) s += (v[k][j].x * v[k][j].x + v[k][j].y * v[k][j].y) + (v[k][j].z * v[k][j].z + v[k][j].w * v[k][j].w);
            const float rs = rsqrtf(wave_sum(s) * (1.f / D) + EPS);
            u32x2* o = (u32x2*)(H + (size_t)t * D) + lane;
#pragma unroll
            for (int j = 0; j < 4; ++j) { const f32x4 g = gp[j], c = sc[k][j], h = sh[k][j], x = v[k][j]; f32x4 y;
                y.x = x.x * rs * g.x * (1.f + c.x) + h.x; y.y = x.y * rs * g.y * (1.f + c.y) + h.y; y.z = x.z * rs * g.z * (1.f + c.z) + h.z; y.w = x.w * rs * g.w * (1.f + c.w) + h.w;
                u32x2 w; w.x = cvt_pk_bf16(y.x, y.y); w.y = cvt_pk_bf16(y.z, y.w); o[64 * j] = w; } } }
    }
}
template <int R>
__device__ __forceinline__ void phase_mid(const Args& a, int G) {
    const int lane = threadIdx.x & 63, wave = threadIdx.x >> 6, gw = blockIdx.x * NWAVES + wave, NW = G * NWAVES;
    const float* ada = (const float*)(a.ws + WS_ADA); bf16_t* H = (bf16_t*)(a.ws + WS_H); const bf16_t* MB = (const bf16_t*)(a.ws + WS_MBUF);
    const float* ss1 = (const float*)(a.ws + WS_SS1); const float* gpost = a.in[13]; const float* gpre = a.in[14];
    f32x4 gq[4], gp2[4];
#pragma unroll
    for (int j = 0; j < 4; ++j) { gq[j] = ((const f32x4*)gpost + lane)[64 * j]; gp2[j] = ((const f32x4*)gpre + lane)[64 * j]; }
    for (int t0 = gw; t0 < T; t0 += R * NW) {
        f32x4 v[R][4], g1[R][4]; u32x2 mw[R][4]; float sp[R];
#pragma unroll
        for (int k = 0; k < R; ++k) { const int t = t0 + k * NW; if (t < T) { int r, tb, S; tok_info(t, r, tb, S);
            const f32x4* xr = (const f32x4*)xrow_ptr(a, t) + lane; const u32x2* mr = (const u32x2*)(MB + (size_t)t * D) + lane; const f32x4* gt = (const f32x4*)(ada + (size_t)r * NADA + 2 * D) + lane;
            sp[k] = ss1[(size_t)t * 16 + (lane & 15)];
#pragma unroll
            for (int j = 0; j < 4; ++j) { v[k][j] = __builtin_nontemporal_load(xr + 64 * j); mw[k][j] = __builtin_nontemporal_load(mr + 64 * j); g1[k][j] = gt[64 * j]; } } }
#pragma unroll
        for (int k = 0; k < R; ++k) { const int t = t0 + k * NW; if (t < T) { int r, tb, S; tok_info(t, r, tb, S);
            const f32x4* shp = (const f32x4*)(ada + (size_t)r * NADA + 3 * D) + lane; const f32x4* scp = (const f32x4*)(ada + (size_t)r * NADA + 4 * D) + lane;
            f32x4 sh[4], sc[4];
#pragma unroll
            for (int j = 0; j < 4; ++j) { sh[j] = shp[64 * j]; sc[j] = scp[64 * j]; }
            float q = sp[k]; q += __shfl_xor(q, 1); q += __shfl_xor(q, 2); q += __shfl_xor(q, 4); q += __shfl_xor(q, 8);
            const float rs1 = rsqrtf(q * (1.f / D) + EPS); float s = 0.f;
#pragma unroll
            for (int j = 0; j < 4; ++j) { f32x4 x = v[k][j]; const f32x4 gg = g1[k][j], gp = gq[j]; const u32x2 m = mw[k][j];
                x.x += gg.x * (bf_lo(m.x) * rs1 * gp.x); x.y += gg.y * (bf_hi(m.x) * rs1 * gp.y); x.z += gg.z * (bf_lo(m.y) * rs1 * gp.z); x.w += gg.w * (bf_hi(m.y) * rs1 * gp.w);
                v[k][j] = x; s += (x.x * x.x + x.y * x.y) + (x.z * x.z + x.w * x.w); }
            const float rs = rsqrtf(wave_sum(s) * (1.f / D) + EPS);
            f32x4* xo = (f32x4*)(a.out + (size_t)t * D) + lane; u32x2* o = (u32x2*)(H + (size_t)t * D) + lane;
#pragma unroll
            for (int j = 0; j < 4; ++j) { const f32x4 x = v[k][j];
                if (G == 256) { u32x2 xb; xb.x = cvt_pk_bf16(x.x, x.y); xb.y = cvt_pk_bf16(x.z, x.w); __builtin_nontemporal_store(xb, (u32x2*)((bf16_t*)(a.ws + WS_X1B) + (size_t)t * D) + lane + 64 * j); }
                else __builtin_nontemporal_store(x, xo + 64 * j);
                const f32x4 g = gp2[j], c = sc[j], h = sh[j]; f32x4 y;
                y.x = x.x * rs * g.x * (1.f + c.x) + h.x; y.y = x.y * rs * g.y * (1.f + c.y) + h.y; y.z = x.z * rs * g.z * (1.f + c.z) + h.z; y.w = x.w * rs * g.w * (1.f + c.w) + h.w;
                u32x2 w; w.x = cvt_pk_bf16(y.x, y.y); w.y = cvt_pk_bf16(y.z, y.w); o[64 * j] = w; } } }
    }
}
template <int R>
__device__ __forceinline__ void phase_final(const Args& a, int G) {
    const int lane = threadIdx.x & 63, wave = threadIdx.x >> 6, gw = blockIdx.x * NWAVES + wave, NW = G * NWAVES;
    const float* ada = (const float*)(a.ws + WS_ADA); const bf16_t* ZB = (const bf16_t*)(a.ws + WS_ZBUF);
    const float* ss2 = (const float*)(a.ws + WS_SS2); const float* gpost = a.in[18];
    f32x4 gq[4];
#pragma unroll
    for (int j = 0; j < 4; ++j) gq[j] = ((const f32x4*)gpost + lane)[64 * j];
    for (int t0 = gw; t0 < T; t0 += R * NW) {
        f32x4 v[R][4], g2[R][4]; u32x2 zw[R][4]; float sp[R];
#pragma unroll
        for (int k = 0; k < R; ++k) { const int t = t0 + k * NW; if (t < T) { int r, tb, S; tok_info(t, r, tb, S);
            const f32x4* xr = (const f32x4*)(a.out + (size_t)t * D) + lane; const u32x2* zr = (const u32x2*)(ZB + (size_t)t * D) + lane; const f32x4* gt = (const f32x4*)(ada + (size_t)r * NADA + 5 * D) + lane;
            sp[k] = ss2[(size_t)t * 16 + (lane & 15)];
#pragma unroll
            for (int j = 0; j < 4; ++j) { v[k][j] = xr[64 * j]; zw[k][j] = zr[64 * j]; g2[k][j] = gt[64 * j]; } } }
#pragma unroll
        for (int k = 0; k < R; ++k) { const int t = t0 + k * NW; if (t < T) {
            float q = sp[k]; q += __shfl_xor(q, 1); q += __shfl_xor(q, 2); q += __shfl_xor(q, 4); q += __shfl_xor(q, 8);
            const float rs2 = rsqrtf(q * (1.f / D) + EPS);
            f32x4* xo = (f32x4*)(a.out + (size_t)t * D) + lane;
#pragma unroll
            for (int j = 0; j < 4; ++j) { f32x4 x = v[k][j]; const f32x4 gg = g2[k][j], gp = gq[j]; const u32x2 z = zw[k][j];
                x.x += gg.x * (bf_lo(z.x) * rs2 * gp.x); x.y += gg.y * (bf_hi(z.x) * rs2 * gp.y); x.z += gg.z * (bf_lo(z.y) * rs2 * gp.z); x.w += gg.w * (bf_hi(z.y) * rs2 * gp.w);
                xo[64 * j] = x; } } }
    }
}
template <int W>
__device__ __forceinline__ void pool_task(const bf16_t* UP, bf16_t* A2, int t0, int g, int lane) {
    constexpr int L = W / 2, NR = 32 + W - 1;
    int r, tb, S; tok_info(t0, r, tb, S);
    const int s0 = t0 - tb;
    unsigned row[NR];
#pragma unroll
    for (int j = 0; j < NR; ++j) { const int p = s0 - L + j; row[j] = (p >= 0 && p < S) ? __builtin_nontemporal_load((const unsigned*)(UP + (size_t)(tb + p) * 512 + g * 128) + lane) : 0u; }
    float slo = 0.f, shi = 0.f;
#pragma unroll
    for (int j = 0; j < W - 1; ++j) { slo += bf_lo(row[j]); shi += bf_hi(row[j]); }
#pragma unroll
    for (int i = 0; i < 32; ++i) {
        slo += bf_lo(row[i + W - 1]); shi += bf_hi(row[i + W - 1]);
        const int s = s0 + i, lo = max(s - L, 0), hi = min(s + (W - 1 - L), S - 1); const float inv = __builtin_amdgcn_rcpf((float)(hi - lo + 1));
        *((unsigned*)(A2 + (size_t)(t0 + i) * 1024 + 512 + g * 128) + lane) = cvt_pk_bf16(slo * inv - bf_lo(row[i + L]), shi * inv - bf_hi(row[i + L]));
        slo -= bf_lo(row[i]); shi -= bf_hi(row[i]);
    }
}
__device__ __forceinline__ void phase_pool(const Args& a, int G) {
    const int lane = threadIdx.x & 63, wave = __builtin_amdgcn_readfirstlane(threadIdx.x >> 6), gw = blockIdx.x * NWAVES + wave, NW = G * NWAVES;
    const bf16_t* UP = (const bf16_t*)(a.ws + WS_UP); bf16_t* A2 = (bf16_t*)(a.ws + WS_A2);
    int k = 0;
    for (int task = gw; task < (T / 32) * 4; task += NW, ++k) {
        const int chunk = task >> 2, g = (task + k) & 3, t0 = chunk * 32;
        if (g == 0) pool_task<2>(UP, A2, t0, 0, lane); else if (g == 1) pool_task<4>(UP, A2, t0, 1, lane); else if (g == 2) pool_task<8>(UP, A2, t0, 2, lane); else pool_task<16>(UP, A2, t0, 3, lane);
    }
}

__device__ __forceinline__ void fft_load_tables(const Args& a, LAS unsigned char* lds) {
    const u32x4* src = (const u32x4*)(a.ws + WS_FC); LAS u32x4* dst = (LAS u32x4*)lds;
    for (int i = threadIdx.x; i < 2 * FT_BYTES / 16; i += NTHR) dst[i] = src[i];
    __syncthreads();
}
__device__ __forceinline__ half8 pack_acc(const f32x4 lo, const f32x4 hi) {
    half8 h; h[0] = (_Float16)lo[0]; h[1] = (_Float16)lo[1]; h[2] = (_Float16)lo[2]; h[3] = (_Float16)lo[3]; h[4] = (_Float16)hi[0]; h[5] = (_Float16)hi[1]; h[6] = (_Float16)hi[2]; h[7] = (_Float16)hi[3]; return h;
}
__device__ __forceinline__ half8 neg_h8(half8 v) { u32x4 u = __builtin_bit_cast(u32x4, v); u.x ^= 0x80008000u; u.y ^= 0x80008000u; u.z ^= 0x80008000u; u.w ^= 0x80008000u; return __builtin_bit_cast(half8, u); }
__device__ __forceinline__ half8 tab_frag(const LAS _Float16* tab, int row, int t, int q) {
    const LAS _Float16* p = tab + row * FT_LD + 32 * t + 4 * q; const half4 c0 = *(const LAS half4*)p, c1 = *(const LAS half4*)(p + 16);
    half8 h; h[0] = c0[0]; h[1] = c0[1]; h[2] = c0[2]; h[3] = c0[3]; h[4] = c1[0]; h[5] = c1[1]; h[6] = c1[2]; h[7] = c1[3]; return h;
}
#define MFMA_H(a, b, c) __builtin_amdgcn_mfma_f32_16x16x32_f16(a, b, c, 0, 0, 0)

struct ItemA { int g, s2, N2, tb, rmul; };
__device__ __forceinline__ ItemA decode_a(int it) {
    ItemA I;
    if (it < 1024) { const int b = it >> 9; I.g = (it >> 7) & 3; I.s2 = it & 127; I.N2 = 128; I.tb = b << 14; I.rmul = 1; }
    else { const int j = it - 1024, b = j >> 6; I.g = (j >> 4) & 3; I.s2 = j & 15; I.N2 = 16; I.tb = TP + (b << 11); I.rmul = 8; }
    return I;
}
__device__ __forceinline__ void fft_pass_a(const Args& a, LAS unsigned char* lds, int G) {
    const LAS _Float16* FC = (const LAS _Float16*)lds; const LAS _Float16* FS = FC + 128 * FT_LD;
    const int lane = threadIdx.x & 63, w = __builtin_amdgcn_readfirstlane(threadIdx.x >> 6), r = lane & 15, q = lane >> 4;
    const _Float16* UF = (const _Float16*)(a.ws + WS_UF); _Float16* T2 = (_Float16*)(a.ws + WS_H); const float2* ROOT = (const float2*)(a.ws + WS_ROOT);
    LAS _Float16* OT = (LAS _Float16*)(lds + 2 * FT_BYTES); constexpr int OTA_LD = 264;
    LAS f32x2_t* TW = (LAS f32x2_t*)(lds + 2 * FT_BYTES + 128 * OTA_LD * 2);
    f32x2_t twn = {1.f, 0.f};
    half8 U[8][4];
#define PA_LOAD(itx, R0) do { const ItemA J = decode_a(itx); const _Float16* ub = UF + (size_t)(J.tb + J.s2) * 512 + J.g * 128 + q * 8; \
        _Pragma("unroll") for (int rt = R0; rt < R0 + 4; ++rt) { const _Float16* p = ub + (size_t)(16 * rt + r) * J.N2 * 512; \
            _Pragma("unroll") for (int t = 0; t < 4; ++t) U[rt][t] = *(const half8*)(p + 32 * t); } } while (0)
#define PA_WRITEOUT(itx) do { const ItemA J = decode_a(itx); _Float16* dst = T2 + (size_t)J.tb * 1024 + (size_t)(J.g * 128) * J.N2 * 256 + (size_t)J.s2 * 256; \
        _Pragma("unroll") for (int i = 0; i < 8; ++i) { const int c = threadIdx.x + i * NTHR, k1 = c >> 5, within = c & 31; \
            const u32x4 vv = *(const LAS u32x4*)((const LAS unsigned char*)OT + k1 * (OTA_LD * 2) + within * 16); \
            *(u32x4*)(dst + (size_t)k1 * J.N2 * 256 + within * 8) = vv; } } while (0)
    int it = blockIdx.x, pit = -1;
    if (it < 1536) { PA_LOAD(it, 0); if (threadIdx.x < 128) { const ItemA J = decode_a(it); { const float2 c_ = ROOT[(J.s2 * (int)threadIdx.x * J.rmul) & 16383]; twn = (f32x2_t){c_.x, c_.y}; } } }
    for (; it < 1536; it += G) {
        const ItemA I = decode_a(it); const int g = I.g, s2 = I.s2, N2 = I.N2, tb = I.tb, rmul = I.rmul;
        PA_LOAD(it, 4);
        if (threadIdx.x < 128) TW[threadIdx.x] = twn;
        half8 ZrB[4], ZiB[4];
        {
            half8 FcB[4], FsB[4];
#pragma unroll
            for (int t = 0; t < 4; ++t) { FcB[t] = *(const LAS half8*)(FC + (16 * w + r) * FT_LD + 32 * t + 8 * q); FsB[t] = *(const LAS half8*)(FS + (16 * w + r) * FT_LD + 32 * t + 8 * q); }
            f32x4 accR[8], accI[8];
#pragma unroll
            for (int rt = 0; rt < 8; ++rt) { f32x4 cr = {0.f, 0.f, 0.f, 0.f}, ci = {0.f, 0.f, 0.f, 0.f};
#pragma unroll
                for (int t = 0; t < 4; ++t) { cr = MFMA_H(U[rt][t], FcB[t], cr); ci = MFMA_H(U[rt][t], FsB[t], ci); }
                accR[rt] = cr; accI[rt] = ci; }
#pragma unroll
            for (int t = 0; t < 4; ++t) { ZrB[t] = pack_acc(accR[2 * t], accR[2 * t + 1]); ZiB[t] = pack_acc(accI[2 * t], accI[2 * t + 1]); }
        }
        if (pit >= 0) PA_WRITEOUT(pit);
        if (it + G < 1536) { PA_LOAD(it + G, 0); if (threadIdx.x < 128) { const ItemA J = decode_a(it + G); { const float2 c_ = ROOT[(J.s2 * (int)threadIdx.x * J.rmul) & 16383]; twn = (f32x2_t){c_.x, c_.y}; } } }
        __syncthreads();
#pragma unroll 1
        for (int kt = 0; kt < 5; ++kt) {
            f32x4 P = {0.f, 0.f, 0.f, 0.f}, Q = P, R = P, S = P;
#pragma unroll
            for (int t = 0; t < 4; ++t) { const half8 fc = tab_frag(FC, 16 * kt + r, t, q), fs = tab_frag(FS, 16 * kt + r, t, q);
                P = MFMA_H(fc, ZrB[t], P); Q = MFMA_H(fs, ZiB[t], Q); R = MFMA_H(fc, ZiB[t], R); S = MFMA_H(fs, ZrB[t], S); }
#pragma unroll
            for (int j = 0; j < 4; ++j) { const int k1 = 16 * kt + 4 * q + j;
                if (kt < 4 || k1 == 64) { const f32x2_t cs = TW[k1]; const float Tr = P[j] - Q[j], Tn = R[j] + S[j];
                    LAS _Float16* o = OT + k1 * OTA_LD + 16 * w + r; o[0] = (_Float16)(Tr * cs.x - Tn * cs.y); o[128] = (_Float16)(-(Tn * cs.x + Tr * cs.y)); }
                if (kt < 4 && k1 != 0) { const int mk = 128 - k1; const f32x2_t cs = TW[mk]; const float Tr = P[j] + Q[j], Tn = R[j] - S[j];
                    LAS _Float16* o = OT + mk * OTA_LD + 16 * w + r; o[0] = (_Float16)(Tr * cs.x - Tn * cs.y); o[128] = (_Float16)(-(Tn * cs.x + Tr * cs.y)); } }
        }
        __syncthreads();
        pit = it;
    }
    if (pit >= 0) PA_WRITEOUT(pit);
#undef PA_WRITEOUT
#undef PA_LOAD
}
__device__ __forceinline__ void fft_pass_b(const Args& a, LAS unsigned char* lds, int G) {
    const LAS _Float16* FC = (const LAS _Float16*)lds; const LAS _Float16* FS = FC + 128 * FT_LD;
    LAS bf16_t* OT = (LAS bf16_t*)(lds + 2 * FT_BYTES); constexpr int OTB_LD = 136;
    const int lane = threadIdx.x & 63, w = __builtin_amdgcn_readfirstlane(threadIdx.x >> 6), r = lane & 15, q = lane >> 4;
    const _Float16* T2 = (const _Float16*)(a.ws + WS_H); bf16_t* A2 = (bf16_t*)(a.ws + WS_A2); const float2* ROOT = (const float2*)(a.ws + WS_ROOT);
    half8 Sel, A16;
#pragma unroll
    for (int jj = 0; jj < 8; ++jj) { Sel[jj] = (8 * q + jj == 16 * (w & 1) + r) ? (_Float16)1.f : (_Float16)0.f;
        const int s2 = 4 * q + (jj & 3); const float2 cs = ROOT[((r * s2) & 15) * 1024]; A16[jj] = (_Float16)(0.25f * (jj < 4 ? cs.x : cs.y)); }
    const f32x4 zero = {0.f, 0.f, 0.f, 0.f};
    {
        half8 Lr[8], Li[8];
#define PB_LOAD(itx) do { const int b_ = (itx) >> 9, g_ = ((itx) >> 7) & 3, k1_ = (itx) & 127; \
        const _Float16* base_ = T2 + (size_t)(b_ << 14) * 1024 + (size_t)(g_ * 128 + k1_) * 128 * 256 + 32 * (w >> 1) + 8 * q; \
        _Pragma("unroll") for (int rt = 0; rt < 8; ++rt) { const _Float16* p = base_ + (16 * rt + r) * 256; Lr[rt] = *(const half8*)p; Li[rt] = *(const half8*)(p + 128); } } while (0)
        int it = blockIdx.x;
        if (it < 1024) PB_LOAD(it);
        for (; it < 1024; it += G) {
            const int b = it >> 9, g = (it >> 7) & 3, k1 = it & 127, tb = b << 14;
            half8 RB[4], IB[4];
            {
                f32x4 Dr[8], Di[8];
#pragma unroll
                for (int rt = 0; rt < 8; ++rt) { Dr[rt] = MFMA_H(Lr[rt], Sel, zero); Di[rt] = MFMA_H(Li[rt], Sel, zero); }
#pragma unroll
                for (int t = 0; t < 4; ++t) { RB[t] = pack_acc(Dr[2 * t], Dr[2 * t + 1]); IB[t] = pack_acc(Di[2 * t], Di[2 * t + 1]); }
            }
            if (it + G < 1024) PB_LOAD(it + G);
            __syncthreads();
#pragma unroll 1
            for (int kt = 0; kt < 5; ++kt) {
                f32x4 C = zero, Dd = zero;
#pragma unroll
                for (int t = 0; t < 4; ++t) { const half8 fc = tab_frag(FC, 16 * kt + r, t, q), fs = tab_frag(FS, 16 * kt + r, t, q);
                    C = MFMA_H(fc, RB[t], C); Dd = MFMA_H(fs, IB[t], Dd); }
#pragma unroll
                for (int j = 0; j < 4; ++j) { const int k2 = 16 * kt + 4 * q + j;
                    if (kt < 4 || k2 == 64) { const float y = C[j] + Dd[j]; OT[k2 * OTB_LD + 16 * w + r] = (bf16_t)(cvt_pk_bf16(y, y) & 0xffffu); }
                    if (kt < 4 && k2 != 0) { const float y = C[j] - Dd[j]; OT[(128 - k2) * OTB_LD + 16 * w + r] = (bf16_t)(cvt_pk_bf16(y, y) & 0xffffu); } }
            }
            __syncthreads();
            bf16_t* dst = A2 + (size_t)(tb + k1) * 1024 + g * 128;
#pragma unroll
            for (int i = 0; i < 4; ++i) { const int c = threadIdx.x + i * NTHR, k2 = c >> 4, ch = c & 15;
                const u32x4 vv = *(const LAS u32x4*)((const LAS unsigned char*)OT + k2 * (OTB_LD * 2) + ch * 16);
                *(u32x4*)(dst + (size_t)k2 * 128 * 1024 + ch * 8) = vv; }
        }
#undef PB_LOAD
    }
    for (int it0 = blockIdx.x; it0 < 4096; it0 += 4 * G) {
        half8 ar[4], ai[4];
#pragma unroll
        for (int u = 0; u < 4; ++u) { const int j = it0 + u * G; if (j < 4096) { const int b = j >> 9, g = (j >> 7) & 3, k1 = j & 127, tb = TP + (b << 11);
            const _Float16* p = T2 + (size_t)tb * 1024 + (size_t)(g * 128 + k1) * 16 * 256 + 32 * (w >> 1) + 8 * q + r * 256;
            ar[u] = *(const half8*)p; ai[u] = *(const half8*)(p + 128); } }
        __syncthreads();
#pragma unroll
        for (int u = 0; u < 4; ++u) { const int j = it0 + u * G; if (j < 4096) {
            const f32x4 Dr = MFMA_H(ar[u], Sel, zero), Di = MFMA_H(ai[u], Sel, zero);
            const half8 Bf = pack_acc(Dr, Di);
            const f32x4 Y = MFMA_H(A16, Bf, zero);
#pragma unroll
            for (int jj = 0; jj < 4; ++jj) { const int k2 = 4 * q + jj; OT[(u * 16 + k2) * OTB_LD + 16 * w + r] = (bf16_t)(cvt_pk_bf16(Y[jj], Y[jj]) & 0xffffu); } } }
        __syncthreads();
#pragma unroll
        for (int i = 0; i < 2; ++i) { const int c = threadIdx.x + i * NTHR, row = c >> 4, ch = c & 15, u = row >> 4, k2 = row & 15; const int j = it0 + u * G;
            if (j < 4096) { const int b = j >> 9, g = (j >> 7) & 3, k1 = j & 127, tb = TP + (b << 11);
                const u32x4 vv = *(const LAS u32x4*)((const LAS unsigned char*)OT + row * (OTB_LD * 2) + ch * 16);
                *(u32x4*)(A2 + (size_t)(tb + k1 + 128 * k2) * 1024 + g * 128 + ch * 8) = vv; } }
    }
}

#define XB_TMO      128
#define XB_XCNT(j)  (256  + 64 * (j))
#define XB_XSUB(j)  (1280 + 64 * (j))
#define XB_XGEN(j)  (2304 + 64 * (j))
#define XB_TOP      3328
#define XB_TOPGEN   3392
#define XCD_BAR_WORDS 3456
#define XB_SPIN_CAP (1u << 18)
__device__ __forceinline__ unsigned xb_ld(unsigned* p)              { return __hip_atomic_load(p, __ATOMIC_RELAXED, __HIP_MEMORY_SCOPE_AGENT); }
__device__ __forceinline__ unsigned xb_add(unsigned* p, unsigned v) { return __hip_atomic_fetch_add(p, v, __ATOMIC_RELAXED, __HIP_MEMORY_SCOPE_AGENT); }
__device__ __forceinline__ unsigned xb_xcc_id() { return (unsigned)__builtin_amdgcn_s_getreg((3 << 11) | 20) & 0xFu; }
#define XB_SPIN(cond, bar) do { unsigned _sp = 0; while (cond) { __builtin_amdgcn_s_sleep(1); \
    if ((++_sp & 255u) == 0u) { if (xb_ld(&(bar)[XB_TMO])) break; if (_sp > XB_SPIN_CAP) { atomicAdd(&(bar)[XB_TMO], 1u); break; } } } } while (0)
struct XcdBarrier { unsigned* bar; unsigned x; volatile LAS unsigned* st; };
__device__ __forceinline__ XcdBarrier xcd_barrier_post(unsigned* bar, volatile LAS unsigned* st) {
    XcdBarrier b; b.bar = bar; b.x = xb_xcc_id(); b.st = st;
    if (threadIdx.x == 0) (void)xb_add(&bar[XB_XCNT(b.x)], 1u);
    return b;
}
__device__ __forceinline__ void xcd_barrier_complete(unsigned* bar, unsigned x, unsigned& nloc, unsigned& nx) {
    const unsigned G = gridDim.x * gridDim.y * gridDim.z;
    unsigned sum, cnt, mine, sp = 0u;
    for (;;) {
        sum = 0u; cnt = 0u; mine = 0u;
#pragma unroll
        for (unsigned j = 0; j < 16; ++j) { const unsigned c = xb_ld(&bar[XB_XCNT(j)]); sum += c; cnt += (c > 0u) ? 1u : 0u; mine = (j == x) ? c : mine; }
        if (sum == G) break;
        __builtin_amdgcn_s_sleep(1);
        if ((++sp & 255u) == 0u) { if (xb_ld(&bar[XB_TMO])) break; if (sp > XB_SPIN_CAP) { atomicAdd(&bar[XB_TMO], 1u); break; } }
    }
    nloc = mine > 0u ? mine : 1u; nx = cnt > 0u ? cnt : 1u;
}
__device__ __forceinline__ void xcd_barrier(const XcdBarrier& b) {
    asm volatile("s_waitcnt vmcnt(0)" ::: "memory");
    __syncthreads();
    if (threadIdx.x == 0) {
        unsigned* bar = b.bar;
        __builtin_amdgcn_s_waitcnt(0);
        unsigned nloc = b.st[0], nx = b.st[1];
        if (nloc == 0u) { xcd_barrier_complete(bar, b.x, nloc, nx); b.st[0] = nloc; b.st[1] = nx; }
        const unsigned old = xb_add(&bar[XB_XSUB(b.x)], 1u);
        const unsigned gen = old / nloc;
        if (old + 1u == (gen + 1u) * nloc) {
            __builtin_amdgcn_fence(__ATOMIC_RELEASE, "agent");
            asm volatile("s_waitcnt vmcnt(0)" ::: "memory");
            const unsigned og = xb_add(&bar[XB_TOP], 1u);
            const unsigned tg = og / nx;
            if (og + 1u == (tg + 1u) * nx) xb_add(&bar[XB_TOPGEN], 1u);
            else XB_SPIN(xb_ld(&bar[XB_TOPGEN]) == tg, bar);
            __builtin_amdgcn_fence(__ATOMIC_ACQUIRE, "agent");
            xb_add(&bar[XB_XGEN(b.x)], 1u);
            asm volatile("s_waitcnt vmcnt(0)" ::: "memory");
        } else {
            XB_SPIN(xb_ld(&bar[XB_XGEN(b.x)]) == gen, bar);
            __builtin_amdgcn_fence(__ATOMIC_ACQUIRE, "agent");
            asm volatile("s_waitcnt vmcnt(0)" ::: "memory");
        }
    }
    __syncthreads();
}

__global__ void __launch_bounds__(NTHR, 2) fwd_megakernel(Args a) {
    extern __shared__ __attribute__((aligned(16))) unsigned char lds_raw[];
    LAS unsigned char* lds = (LAS unsigned char*)lds_raw;
    cg::grid_group grid = cg::this_grid();
    const int G = gridDim.x;
    unsigned char* ws = a.ws;
    volatile LAS unsigned* bst = (volatile LAS unsigned*)(lds + LDS_BYTES - 64);
    if (threadIdx.x == 0) { bst[0] = 0u; bst[1] = 0u; }
    __syncthreads();
    const XcdBarrier xbar = xcd_barrier_post((unsigned*)(ws + WS_BAR), bst);

    phase_prep(a, lds, G);
    grid.sync();
    phase_norm1<4>(a, G);
    xcd_barrier(xbar);
    {
        pg8::Gemm g{(const bf16_t*)(ws + WS_H), (const bf16_t*)(ws + WS_W1T), T, 3072, 1024, 1024, 1024, 0, 0}; pg8::StaticOrder S; S.init(T, 3072, G, (int)blockIdx.x);
        pg8::EpiG1 E{(_Float16*)(ws + WS_UF), (bf16_t*)(ws + WS_UP), (bf16_t*)(ws + WS_GATES)};
        pg8::gemm_phase(lds, g, S, E);
    }
    xcd_barrier(xbar);
    fft_load_tables(a, lds);
    fft_pass_a(a, lds, G);
    phase_pool(a, G);
    xcd_barrier(xbar);
    fft_pass_b(a, lds, G);
    xcd_barrier(xbar);
    {
        pg8::TwoPartOrder S; S.init(T, 1024, G, (int)blockIdx.x);
        pg8::Gemm g{(const bf16_t*)(ws + WS_A2), (const bf16_t*)(ws + WS_W2T), T, 1024, 512, 1024, 1024, 1024, 1024};
        pg8::EpiMix2 E{(bf16_t*)(ws + WS_H), (const bf16_t*)(ws + WS_GATES)};
        pg8::gemm_phase(lds, g, S, E);
    }
    xcd_barrier(xbar);
    {
        pg8::Gemm g{(const bf16_t*)(ws + WS_H), (const bf16_t*)(ws + WS_W3T), T, 1024, 1024, 1024, 1024, 0, 0}; pg8::StaticOrder S; S.init(T, 1024, G, (int)blockIdx.x);
        pg8::EpiRowSS E{(bf16_t*)(ws + WS_MBUF), (float*)(ws + WS_SS1)};
        pg8::gemm_phase(lds, g, S, E);
    }
    xcd_barrier(xbar);
    phase_mid<2>(a, G);
    xcd_barrier(xbar);
    {
        pg8::Gemm g{(const bf16_t*)(ws + WS_H), (const bf16_t*)(ws + WS_W4T), T, 2 * FF, 1024, 1024, 1024, 0, 0}; pg8::StaticOrder S; S.init(T, 2 * FF, G, (int)blockIdx.x);
        pg8::EpiSwiGLU E{(bf16_t*)(ws + WS_SBUF)};
        pg8::gemm_phase(lds, g, S, E);
    }
    xcd_barrier(xbar);
    if (G == 256) {
        pg8::Gemm g{(const bf16_t*)(ws + WS_SBUF), (const bf16_t*)(ws + WS_W5T), T, 1024, FF, FF, FF, 0, 0}; pg8::StaticOrder S; S.init(T, 1024, G, (int)blockIdx.x);
        pg8::EpiFinal E{a.out, (const bf16_t*)(ws + WS_X1B), (const float*)(ws + WS_ADA), a.in[18], (float*)(ws + WS_SSX), (unsigned*)(ws + WS_XCTR), (LAS float*)(lds + 131072)};
        pg8::gemm_phase(lds, g, S, E);
    } else {
        {
            pg8::Gemm g{(const bf16_t*)(ws + WS_SBUF), (const bf16_t*)(ws + WS_W5T), T, 1024, FF, FF, FF, 0, 0}; pg8::StaticOrder S; S.init(T, 1024, G, (int)blockIdx.x);
            pg8::EpiRowSS E{(bf16_t*)(ws + WS_ZBUF), (float*)(ws + WS_SS2)};
            pg8::gemm_phase(lds, g, S, E);
        }
        xcd_barrier(xbar);
        phase_final<4>(a, G);
    }
}

extern "C" void kernel_launch(void* const* d_in, const int* in_sizes, int n_in, void* d_out, int out_size, void* d_ws, size_t ws_size, hipStream_t stream) {
    static int grid = 0;
    if (grid == 0) {
        if (n_in != 19 || out_size != T * D || ws_size < WS_END) { fprintf(stderr, "kernel_launch: unexpected shapes (n_in %d, out %d, ws %zu)\n", n_in, out_size, ws_size); grid = -1; return; }
        int dev = 0, cus = 0, per_cu = 0;
        if (hipGetDevice(&dev) != hipSuccess || hipDeviceGetAttribute(&cus, hipDeviceAttributeMultiprocessorCount, dev) != hipSuccess) { grid = -1; return; }
        if (hipFuncSetAttribute((const void*)fwd_megakernel, hipFuncAttributeMaxDynamicSharedMemorySize, LDS_BYTES) != hipSuccess) { fprintf(stderr, "kernel_launch: hipFuncSetAttribute failed\n"); grid = -1; return; }
        if (hipOccupancyMaxActiveBlocksPerMultiprocessor(&per_cu, (const void*)fwd_megakernel, NTHR, LDS_BYTES) != hipSuccess || per_cu < 1) { fprintf(stderr, "kernel_launch: occupancy query failed (%d)\n", per_cu); (void)hipGetLastError(); grid = -1; return; }
        grid = cus * per_cu;
    }
    if (grid < 0) return;
    if (hipMemsetAsync((char*)d_ws + WS_BAR, 0, WS_MEMSET_BYTES, stream) != hipSuccess) { fprintf(stderr, "kernel_launch: memset failed\n"); return; }
    Args a{};
    for (int i = 0; i < 19; ++i) a.in[i] = (const float*)d_in[i];
    a.out = (float*)d_out; a.ws = (unsigned char*)d_ws;
    void* args[] = {&a};
    hipError_t e = hipLaunchCooperativeKernel((const void*)fwd_megakernel, dim3(grid), dim3(NTHR), args, LDS_BYTES, stream);
    if (e != hipSuccess) fprintf(stderr, "kernel_launch: cooperative launch failed: %s (grid %d)\n", hipGetErrorString(e), grid);
}
```

```cpp
#include <hip/hip_runtime.h>
#include <hip/hip_cooperative_groups.h>
#include <cstdio>
#include <cstdint>
namespace cg = cooperative_groups;

#define LAS __attribute__((address_space(3)))
typedef unsigned short bf16_t;
typedef short bf16x8 __attribute__((ext_vector_type(8)));
typedef _Float16 half8 __attribute__((ext_vector_type(8)));
typedef _Float16 half4 __attribute__((ext_vector_type(4)));
typedef _Float16 half2v __attribute__((ext_vector_type(2)));
typedef float f32x4 __attribute__((ext_vector_type(4)));
typedef unsigned u32x4 __attribute__((ext_vector_type(4)));
typedef unsigned u32x2 __attribute__((ext_vector_type(2)));

constexpr int D = 1024, TP = 2 * 16384, TS = 8 * 2048, T = TP + TS;
constexpr int NB = 10;
constexpr int FF = 2816, NADA = 6 * D;
constexpr float EPS = 1e-6f;
constexpr int NWAVES = 8, NTHR = 512;

constexpr size_t MiB = 1u << 20;
constexpr size_t WS_ADA = 0;
constexpr size_t WS_BAR = 512 * 1024;
constexpr size_t WS_XCTR = 512 * 1024 + 16384;
constexpr size_t WS_MEMSET_BYTES = 16384 + 2 * 192 * 64;
constexpr size_t WS_ROOT = 768 * 1024;
constexpr size_t WS_FC = 1 * MiB;
constexpr int FT_LD = 136, FT_BYTES = 128 * FT_LD * 2;
constexpr size_t WS_W1T = 2 * MiB;
constexpr size_t WS_W2T = 8 * MiB;
constexpr size_t WS_W3T = 10 * MiB;
constexpr size_t WS_W4T = 12 * MiB;
constexpr size_t WS_W5T = 23 * MiB;
constexpr size_t WS_H = 32 * MiB;
constexpr size_t WS_GATES = 128 * MiB;
constexpr size_t WS_UF = 320 * MiB;
constexpr size_t WS_UP = 368 * MiB;
constexpr size_t WS_A2 = 416 * MiB;
constexpr size_t WS_MBUF = 320 * MiB;
constexpr size_t WS_SBUF = 128 * MiB;
constexpr size_t WS_ZBUF = 416 * MiB;
constexpr size_t WS_SS1 = 128 * MiB;
constexpr size_t WS_SS2 = 32 * MiB;
constexpr size_t WS_SSX = 28 * MiB + 512 * 1024;
constexpr size_t WS_X1B = 416 * MiB;
constexpr size_t WS_END = 512 * MiB;

constexpr int LDS_BYTES = 147456;

typedef __bf16 bf16x2_t __attribute__((ext_vector_type(2)));
typedef float f32x2_t __attribute__((ext_vector_type(2)));
__device__ __forceinline__ unsigned cvt_pk_bf16(float lo, float hi) { const f32x2_t v = {lo, hi}; const bf16x2_t b = __builtin_convertvector(v, bf16x2_t); return __builtin_bit_cast(unsigned, b); }
__device__ __forceinline__ unsigned pk_f16(float lo, float hi) { half2v h = {(_Float16)lo, (_Float16)hi}; return __builtin_bit_cast(unsigned, h); }
__device__ __forceinline__ float bf_lo(unsigned w) { return __builtin_bit_cast(float, w << 16); }
__device__ __forceinline__ float bf_hi(unsigned w) { return __builtin_bit_cast(float, w & 0xffff0000u); }
__device__ __forceinline__ float sigmoid_f(float x) { return __builtin_amdgcn_rcpf(1.f + __expf(-x)); }
__device__ __forceinline__ float wave_sum(float v) {
#pragma unroll
    for (int o = 1; o < 64; o <<= 1) v += __shfl_xor(v, o);
    return v;
}
__device__ __forceinline__ void tok_info(int t, int& r, int& tb, int& S) {
    if (t < TP) { r = t >> 14; tb = r << 14; S = 16384; }
    else { const int j = (t - TP) >> 11; r = 2 + j; tb = TP + (j << 11); S = 2048; }
}

namespace pg8 {
constexpr int BM = 256, BK = 64, HALF = 128, HTB = HALF * BK * 2, NXCD = 8, WGM = 8;
__host__ __device__ __forceinline__ int lds_byte(int r, int c) { const int st = (r >> 4) * 2 + (c >> 5), rr = r & 15, cc = c & 31, ob = rr * 64 + cc * 2; return st * 1024 + (ob ^ (((ob >> 9) & 1) << 5)); }
__host__ __device__ __forceinline__ void stage_rc(int b, int& R, int& C) { const int st = b / 1024, sb = b % 1024, swz = sb ^ (((sb >> 9) & 1) << 5); R = (st >> 1) * 16 + swz / 64; C = (st & 1) * 32 + (swz % 64) / 2; }
__host__ __device__ __forceinline__ int perm32(int rho) { const int n = rho >> 4, i = rho & 15; return 8 * (i >> 2) + 4 * n + (i & 3); }

struct Unit { int pm, pn, part; };
struct Gemm { const bf16_t* A; const bf16_t* Bt; int M, N, K, lda, ldb, poffA, poffB; };

struct StaticOrder {
    int nM, nN, nwg, G, c;
    __device__ void init(int M, int N, int G_, int c_) { nM = M / BM; nN = N / BM; nwg = nM * nN; G = G_; c = c_; }
    __device__ bool next(int i, Unit& u) const {
        const long L = (long)i * G + c; if (L >= nwg) return false;
        int wgid = (int)L; { const int q = nwg / NXCD, r = nwg % NXCD, xcd = wgid % NXCD, off = wgid / NXCD; wgid = (xcd < r ? xcd * (q + 1) : r * (q + 1) + (xcd - r) * q) + off; }
        const int nig = WGM * nN, gid = wgid / nig, fm = gid * WGM, gsz = (nM - fm) < WGM ? (nM - fm) : WGM;
        u.pm = fm + ((wgid % nig) % gsz); u.pn = (wgid % nig) / gsz; u.part = 0; return true;
    }
};
struct TwoPartOrder {
    StaticOrder S;
    __device__ void init(int M, int N, int G_, int c_) { S.init(M, N, G_, c_); }
    __device__ bool next(int i, Unit& u) const { if (!S.next(i >> 1, u)) return false; u.part = i & 1; return true; }
};

template <class Epi, class Sched>
__device__ __forceinline__ void gemm_phase(LAS unsigned char* lds, const Gemm g, const Sched& S, const Epi& E) {
    int tid = threadIdx.x; asm volatile("" : "+v"(tid));
    const int wid = __builtin_amdgcn_readfirstlane(tid >> 6), lane = tid & 63, wr = wid >> 2, wc = wid & 3, fr = lane & 15, fq = lane >> 4;
    const int K = g.K, nt = K / BK;
    unsigned voffA[2], voffB[2];
#pragma unroll
    for (int i = 0; i < 2; ++i) { int R, C; stage_rc(tid * 16 + i * 8192, R, C); const int Rb = (R & ~31) + perm32(R & 31);
        voffA[i] = (unsigned)(R * g.lda + C) * 2u; voffB[i] = (unsigned)(Rb * g.ldb + C) * 2u; }
    const size_t kstep = (size_t)(BK * 2);
    const size_t hstepA = (size_t)HALF * g.lda * 2, hstepB = (size_t)HALF * g.ldb * 2;
    const size_t tstepA = 2 * hstepA, tstepB = 2 * hstepB;
    const unsigned ldsw = (unsigned)wid * 1024u;
    const int aoff = lds_byte(wr * 64 + fr, fq * 8), boff = lds_byte(wc * 32 + fr, fq * 8);
#define PG8_SA(b, h) (((b) * 2 + (h)) * HTB)
#define PG8_SB(b, h) ((4 + (b) * 2 + (h)) * HTB)
#define PG8_STAGE(bufoff, gbase, voff) do { _Pragma("unroll") for (int _i = 0; _i < 2; ++_i) \
        __builtin_amdgcn_global_load_lds((const unsigned*)((const char*)(gbase) + (voff)[_i]), (LAS unsigned*)(lds + (bufoff) + ldsw + _i * 8192), 16, 0, 0); } while (0)
#define PG8_LDA(dst, b, h) do { _Pragma("unroll") for (int m = 0; m < 4; ++m) _Pragma("unroll") for (int k = 0; k < 2; ++k) dst[m][k] = *(const LAS bf16x8*)(lds + PG8_SA(b, h) + aoff + m * 2048 + k * 1024); } while (0)
#define PG8_LDB(dst, b, h) do { _Pragma("unroll") for (int n = 0; n < 2; ++n) _Pragma("unroll") for (int k = 0; k < 2; ++k) dst[n][k] = *(const LAS bf16x8*)(lds + PG8_SB(b, h) + boff + n * 2048 + k * 1024); } while (0)
#define PG8_MMA(ai, bj, At, Bt) do { __builtin_amdgcn_s_setprio(1); _Pragma("unroll") for (int m = 0; m < 4; ++m) _Pragma("unroll") for (int n = 0; n < 2; ++n) _Pragma("unroll") for (int k = 0; k < 2; ++k) \
        acc[ai][bj][m][n] = __builtin_amdgcn_mfma_f32_16x16x32_bf16(Bt[n][k], At[m][k], acc[ai][bj][m][n], 0, 0, 0); __builtin_amdgcn_s_setprio(0); } while (0)
#define PG8_WAIT_V(n) asm volatile("s_waitcnt vmcnt(" #n ")" ::: "memory")
#define PG8_WAIT_L(n) asm volatile("s_waitcnt lgkmcnt(" #n ")" ::: "memory")
#define PG8_BAR __builtin_amdgcn_s_barrier()
#define PG8_SCHED __builtin_amdgcn_sched_barrier(0)
    Unit cur, nxt; int ui = 0;
    if (!S.next(0, cur)) return;
    f32x4 acc[2][2][4][2];
#pragma unroll
    for (int a = 0; a < 2; ++a)
#pragma unroll
        for (int b = 0; b < 2; ++b)
#pragma unroll
            for (int m = 0; m < 4; ++m)
#pragma unroll
                for (int n = 0; n < 2; ++n) acc[a][b][m][n] = (f32x4){0.f, 0.f, 0.f, 0.f};
    bf16x8 At[4][2], B0[2][2], B1[2][2];
    const char* cA = (const char*)g.A + (size_t)cur.pm * tstepA + (size_t)cur.part * g.poffA; const char* cB = (const char*)g.Bt + (size_t)cur.pn * tstepB + (size_t)cur.part * g.poffB;
    PG8_STAGE(PG8_SB(0, 0), cB, voffB); PG8_STAGE(PG8_SB(0, 1), cB + hstepB, voffB); PG8_STAGE(PG8_SA(0, 0), cA, voffA); PG8_STAGE(PG8_SA(0, 1), cA + hstepA, voffA);
    if (wr == 1) PG8_BAR;
    PG8_WAIT_V(2); PG8_BAR;
    PG8_STAGE(PG8_SB(1, 0), cB + kstep, voffB); PG8_STAGE(PG8_SA(1, 0), cA + kstep, voffA); PG8_STAGE(PG8_SB(1, 1), cB + hstepB + kstep, voffB);
    PG8_WAIT_V(6); PG8_BAR;
    for (;;) {
        const bool has_next = S.next(ui + 1, nxt);
        const char* nA = has_next ? (const char*)g.A + (size_t)nxt.pm * tstepA + (size_t)nxt.part * g.poffA : cA; const char* nB = has_next ? (const char*)g.Bt + (size_t)nxt.pn * tstepB + (size_t)nxt.part * g.poffB : cB;
        for (int t = 0; t < nt; t += 2) {
            const bool last = (t == nt - 2);
            const char* a1 = cA + (size_t)(t + 1) * kstep;
            const char* a2 = last ? nA : cA + (size_t)(t + 2) * kstep; const char* b2 = last ? nB : cB + (size_t)(t + 2) * kstep;
            const char* a3 = a2 + kstep; const char* b3 = b2 + kstep;
            PG8_LDB(B0, 0, 0); PG8_LDB(B1, 0, 1); PG8_SCHED; PG8_LDA(At, 0, 0); PG8_STAGE(PG8_SA(1, 1), a1 + hstepA, voffA);
            PG8_WAIT_V(8); PG8_WAIT_L(0); PG8_BAR; PG8_MMA(0, 0, At, B0); PG8_MMA(0, 1, At, B1); PG8_BAR; PG8_SCHED;
            PG8_LDA(At, 0, 1); PG8_STAGE(PG8_SB(0, 0), b2, voffB); PG8_STAGE(PG8_SB(0, 1), b2 + hstepB, voffB); PG8_STAGE(PG8_SA(0, 0), a2, voffA);
            PG8_WAIT_V(8); PG8_WAIT_L(0); PG8_BAR; PG8_MMA(1, 0, At, B0); PG8_MMA(1, 1, At, B1); PG8_BAR; PG8_SCHED;
            PG8_LDB(B0, 1, 0); PG8_LDB(B1, 1, 1); PG8_SCHED; PG8_LDA(At, 1, 0); PG8_STAGE(PG8_SA(0, 1), a2 + hstepA, voffA);
            PG8_WAIT_V(8); PG8_WAIT_L(0); PG8_BAR; PG8_MMA(0, 0, At, B0); PG8_MMA(0, 1, At, B1); PG8_BAR; PG8_SCHED;
            PG8_LDA(At, 1, 1); PG8_STAGE(PG8_SB(1, 0), b3, voffB); PG8_STAGE(PG8_SB(1, 1), b3 + hstepB, voffB); PG8_STAGE(PG8_SA(1, 0), a3, voffA);
            PG8_WAIT_V(8); PG8_WAIT_L(0); PG8_BAR; PG8_MMA(1, 0, At, B0); PG8_MMA(1, 1, At, B1); PG8_BAR; PG8_SCHED;
        }
        if (wr == 0) PG8_BAR;
        E(acc, cur, wr, wc, fr, fq);
        if (!has_next) break;
        if (!(Epi::TWO_PART && cur.part == 0)) {
#pragma unroll
        for (int a = 0; a < 2; ++a)
#pragma unroll
            for (int b = 0; b < 2; ++b)
#pragma unroll
                for (int m = 0; m < 4; ++m)
#pragma unroll
                    for (int n = 0; n < 2; ++n) acc[a][b][m][n] = (f32x4){0.f, 0.f, 0.f, 0.f};
        }
        cur = nxt; cA = nA; cB = nB; ++ui;
        if (wr == 1) PG8_BAR;
    }
    PG8_WAIT_V(0);
    PG8_BAR;
#undef PG8_SA
#undef PG8_SB
#undef PG8_STAGE
#undef PG8_LDA
#undef PG8_LDB
#undef PG8_MMA
#undef PG8_WAIT_V
#undef PG8_WAIT_L
#undef PG8_BAR
#undef PG8_SCHED
}

typedef f32x4 Acc[2][2][4][2];

struct EpiG1 {
    static constexpr bool TWO_PART = false;
    _Float16* UF; bf16_t* UP; bf16_t* GT;
    __device__ __forceinline__ void operator()(const Acc& acc, const Unit& u, int wr, int wc, int fr, int fq) const {
        const int row0 = u.pm * BM + wr * 64 + fr, c0 = wc * 32 + 8 * fq, pn = u.pn;
#pragma unroll
        for (int ai = 0; ai < 2; ++ai)
#pragma unroll
            for (int m = 0; m < 4; ++m) { const size_t row = (size_t)(row0 + ai * HALF + m * 16);
#pragma unroll
                for (int bj = 0; bj < 2; ++bj) { const f32x4 v0 = acc[ai][bj][m][0], v1 = acc[ai][bj][m][1]; const int c = c0 + bj * HALF; u32x4 w;
                    if (pn < 2) { w.x = pk_f16(v0[0], v0[1]); w.y = pk_f16(v0[2], v0[3]); w.z = pk_f16(v1[0], v1[1]); w.w = pk_f16(v1[2], v1[3]);
                        *(u32x4*)(UF + row * 512 + pn * 256 + c) = w; }
                    else if (pn < 4) { w.x = cvt_pk_bf16(v0[0], v0[1]); w.y = cvt_pk_bf16(v0[2], v0[3]); w.z = cvt_pk_bf16(v1[0], v1[1]); w.w = cvt_pk_bf16(v1[2], v1[3]);
                        *(u32x4*)(UP + row * 512 + (pn - 2) * 256 + c) = w; }
                    else if (bj == 0) {
                        const f32x4 q0 = acc[ai][1][m][0], q1 = acc[ai][1][m][1]; float rt[8], sp[8];
#pragma unroll
                        for (int e = 0; e < 4; ++e) { const float ef0 = __expf(-v0[e]), ep0 = fminf(__expf(-q0[e]), 1e30f), ef1 = __expf(-v1[e]), ep1 = fminf(__expf(-q1[e]), 1e30f);
                            sp[e] = __builtin_amdgcn_rcpf(1.f + ep0); rt[e] = (1.f + ep0) * __builtin_amdgcn_rcpf(1.f + ef0); sp[4 + e] = __builtin_amdgcn_rcpf(1.f + ep1); rt[4 + e] = (1.f + ep1) * __builtin_amdgcn_rcpf(1.f + ef1); }
                        const int ch = (pn - 4) * 128 + c0;
                        w.x = cvt_pk_bf16(rt[0], rt[1]); w.y = cvt_pk_bf16(rt[2], rt[3]); w.z = cvt_pk_bf16(rt[4], rt[5]); w.w = cvt_pk_bf16(rt[6], rt[7]);
                        __builtin_nontemporal_store(w, (u32x4*)(GT + row * 2048 + ch));
                        w.x = cvt_pk_bf16(sp[0], sp[1]); w.y = cvt_pk_bf16(sp[2], sp[3]); w.z = cvt_pk_bf16(sp[4], sp[5]); w.w = cvt_pk_bf16(sp[6], sp[7]);
                        __builtin_nontemporal_store(w, (u32x4*)(GT + row * 2048 + 1024 + ch)); } } }
    }
};
struct EpiMix2 {
    static constexpr bool TWO_PART = true;
    bf16_t* MIX; const bf16_t* GT;
    __device__ __forceinline__ void operator()(Acc& acc, const Unit& u, int wr, int wc, int fr, int fq) const {
        const int row0 = u.pm * BM + wr * 64 + fr, c0 = u.pn * BM + wc * 32 + 8 * fq;
#pragma unroll
        for (int ai = 0; ai < 2; ++ai)
#pragma unroll
            for (int m = 0; m < 4; ++m) { const size_t row = (size_t)(row0 + ai * HALF + m * 16);
#pragma unroll
                for (int bj = 0; bj < 2; ++bj) { const int c = c0 + bj * HALF;
                    const u32x4 gq = __builtin_nontemporal_load((const u32x4*)(GT + row * 2048 + (u.part == 0 ? 0 : 1024) + c));
                    const float p[8] = {bf_lo(gq.x), bf_hi(gq.x), bf_lo(gq.y), bf_hi(gq.y), bf_lo(gq.z), bf_hi(gq.z), bf_lo(gq.w), bf_hi(gq.w)};
                    if (u.part == 0) {
#pragma unroll
                        for (int e = 0; e < 4; ++e) { acc[ai][bj][m][0][e] *= p[e]; acc[ai][bj][m][1][e] *= p[4 + e]; }
                    } else {
                        const f32x4 v0 = acc[ai][bj][m][0], v1 = acc[ai][bj][m][1];
                        u32x4 w; w.x = cvt_pk_bf16(v0[0] * p[0], v0[1] * p[1]); w.y = cvt_pk_bf16(v0[2] * p[2], v0[3] * p[3]); w.z = cvt_pk_bf16(v1[0] * p[4], v1[1] * p[5]); w.w = cvt_pk_bf16(v1[2] * p[6], v1[3] * p[7]);
                        *(u32x4*)(MIX + row * 1024 + c) = w; } } }
    }
};
struct EpiRowSS {
    static constexpr bool TWO_PART = false;
    bf16_t* O; float* ss;
    __device__ __forceinline__ void operator()(const Acc& acc, const Unit& u, int wr, int wc, int fr, int fq) const {
        const int row0 = u.pm * BM + wr * 64 + fr, c0 = u.pn * BM + wc * 32 + 8 * fq;
#pragma unroll
        for (int ai = 0; ai < 2; ++ai)
#pragma unroll
            for (int m = 0; m < 4; ++m) { const size_t row = (size_t)(row0 + ai * HALF + m * 16); float p = 0.f;
#pragma unroll
                for (int bj = 0; bj < 2; ++bj) { const f32x4 v0 = acc[ai][bj][m][0], v1 = acc[ai][bj][m][1]; const int c = c0 + bj * HALF;
                    p += (v0[0] * v0[0] + v0[1] * v0[1]) + (v0[2] * v0[2] + v0[3] * v0[3]) + (v1[0] * v1[0] + v1[1] * v1[1]) + (v1[2] * v1[2] + v1[3] * v1[3]);
                    u32x4 w; w.x = cvt_pk_bf16(v0[0], v0[1]); w.y = cvt_pk_bf16(v0[2], v0[3]); w.z = cvt_pk_bf16(v1[0], v1[1]); w.w = cvt_pk_bf16(v1[2], v1[3]);
                    *(u32x4*)(O + row * 1024 + c) = w; }
                p += __shfl_xor(p, 16); p += __shfl_xor(p, 32);
                if (fq == 0) ss[row * 16 + u.pn * 4 + wc] = p; }
    }
};
struct EpiFinal {
    static constexpr bool TWO_PART = false;
    float* out; const bf16_t* x1b; const float* ada; const float* gpost; float* ssx; unsigned* ctr; LAS float* xl;
    __device__ __forceinline__ void operator()(const Acc& acc, const Unit& u, int wr, int wc, int fr, int fq) const {
        const int tid = threadIdx.x, lrow0 = wr * 64 + fr;
#pragma unroll
        for (int ai = 0; ai < 2; ++ai)
#pragma unroll
            for (int m = 0; m < 4; ++m) { float p = 0.f;
#pragma unroll
                for (int bj = 0; bj < 2; ++bj) { const f32x4 v0 = acc[ai][bj][m][0], v1 = acc[ai][bj][m][1];
                    p += (v0[0] * v0[0] + v0[1] * v0[1]) + (v0[2] * v0[2] + v0[3] * v0[3]) + (v1[0] * v1[0] + v1[1] * v1[1]) + (v1[2] * v1[2] + v1[3] * v1[3]); }
                p += __shfl_xor(p, 16); p += __shfl_xor(p, 32);
                if (fq == 0) xl[wc * 256 + ai * HALF + m * 16 + lrow0] = p; }
        __syncthreads();
        float* slot = ssx + ((size_t)u.pm * 4) * 256;
        if (tid < 256) { const float sv = (xl[tid] + xl[256 + tid]) + (xl[512 + tid] + xl[768 + tid]);
            __hip_atomic_store((unsigned*)(slot + u.pn * 256 + tid), __builtin_bit_cast(unsigned, sv), __ATOMIC_RELAXED, __HIP_MEMORY_SCOPE_AGENT); }
        asm volatile("s_waitcnt vmcnt(0)" ::: "memory");
        __syncthreads();
        if (tid == 0) { unsigned* c = ctr + u.pm * 16;
            __hip_atomic_fetch_add(c, 1u, __ATOMIC_RELAXED, __HIP_MEMORY_SCOPE_AGENT);
            unsigned sp = 0; while (__hip_atomic_load(c, __ATOMIC_RELAXED, __HIP_MEMORY_SCOPE_AGENT) < 4u) { __builtin_amdgcn_s_sleep(1); if (++sp > (1u << 22)) break; } }
        __syncthreads();
        if (tid < 256) { float sv = 0.f;
#pragma unroll
            for (int pn = 0; pn < 4; ++pn) sv += __builtin_bit_cast(float, __hip_atomic_load((unsigned*)(slot + pn * 256 + tid), __ATOMIC_RELAXED, __HIP_MEMORY_SCOPE_AGENT));
            xl[1024 + tid] = rsqrtf(sv * (1.f / D) + EPS); }
        __syncthreads();
        int r, tb, S; tok_info(u.pm * BM, r, tb, S);
        const int c0 = u.pn * BM + wc * 32 + 8 * fq;
        float gg[2][8];
#pragma unroll
        for (int bj = 0; bj < 2; ++bj) { const float* gt = ada + (size_t)r * NADA + 5 * D + c0 + bj * HALF; const float* gp = gpost + c0 + bj * HALF;
            const f32x4 a0 = *(const f32x4*)gt, a1 = *(const f32x4*)(gt + 4), b0 = *(const f32x4*)gp, b1 = *(const f32x4*)(gp + 4);
#pragma unroll
            for (int e = 0; e < 4; ++e) { gg[bj][e] = a0[e] * b0[e]; gg[bj][4 + e] = a1[e] * b1[e]; } }
#pragma unroll
        for (int ai = 0; ai < 2; ++ai)
#pragma unroll
            for (int m = 0; m < 4; ++m) { const int lr = ai * HALF + m * 16 + lrow0; const float rs = xl[1024 + lr]; float* orow = out + (size_t)(u.pm * BM + lr) * D + c0;
#pragma unroll
                for (int bj = 0; bj < 2; ++bj) { const u32x4 xb = __builtin_nontemporal_load((const u32x4*)(x1b + (size_t)(u.pm * BM + lr) * D + c0 + bj * HALF));
                    f32x4 x0 = {bf_lo(xb.x), bf_hi(xb.x), bf_lo(xb.y), bf_hi(xb.y)}, x1 = {bf_lo(xb.z), bf_hi(xb.z), bf_lo(xb.w), bf_hi(xb.w)}; const f32x4 v0 = acc[ai][bj][m][0], v1 = acc[ai][bj][m][1];
#pragma unroll
                    for (int e = 0; e < 4; ++e) { x0[e] += gg[bj][e] * (v0[e] * rs); x1[e] += gg[bj][4 + e] * (v1[e] * rs); }
                    __builtin_nontemporal_store(x0, (f32x4*)(orow + bj * HALF)); __builtin_nontemporal_store(x1, (f32x4*)(orow + bj * HALF + 4)); } }
    }
};
struct EpiSwiGLU {
    static constexpr bool TWO_PART = false;
    bf16_t* SB;
    __device__ __forceinline__ void operator()(const Acc& acc, const Unit& u, int wr, int wc, int fr, int fq) const {
        const int row0 = u.pm * BM + wr * 64 + fr, c0 = u.pn * HALF + wc * 32 + 8 * fq;
#pragma unroll
        for (int ai = 0; ai < 2; ++ai)
#pragma unroll
            for (int m = 0; m < 4; ++m) { const size_t row = (size_t)(row0 + ai * HALF + m * 16);
                const f32x4 a0 = acc[ai][0][m][0], a1 = acc[ai][0][m][1], b0 = acc[ai][1][m][0], b1 = acc[ai][1][m][1];
                float o[8];
#pragma unroll
                for (int i = 0; i < 4; ++i) { o[i] = a0[i] * sigmoid_f(a0[i]) * b0[i]; o[4 + i] = a1[i] * sigmoid_f(a1[i]) * b1[i]; }
                u32x4 w; w.x = cvt_pk_bf16(o[0], o[1]); w.y = cvt_pk_bf16(o[2], o[3]); w.z = cvt_pk_bf16(o[4], o[5]); w.w = cvt_pk_bf16(o[6], o[7]);
                __builtin_nontemporal_store(w, (u32x4*)(SB + row * FF + c0)); }
    }
};
}

struct Args { const float* in[19]; float* out; unsigned char* ws; };

template <class Src4>
__device__ __forceinline__ void wave_transpose(Src4 src4, bf16_t* out, int ldo, int k0, int n0, int ocol0, int orow0, LAS float* scr, int lane) {
    f32x4 v[8];
#pragma unroll
    for (int i = 0; i < 8; ++i) v[i] = src4(k0 + 8 * i + (lane >> 3), n0 + 4 * (lane & 7));
#pragma unroll
    for (int i = 0; i < 8; ++i) { LAS float* d = scr + (8 * i + (lane >> 3)) * 33 + 4 * (lane & 7); d[0] = v[i].x; d[1] = v[i].y; d[2] = v[i].z; d[3] = v[i].w; }
    asm volatile("s_waitcnt lgkmcnt(0)" ::: "memory");
    const int c = lane & 7;
#pragma unroll
    for (int j = 0; j < 4; ++j) { const int n = (lane >> 3) + 8 * j; const LAS float* sp = scr + (8 * c) * 33 + n;
        u32x4 o; o.x = cvt_pk_bf16(sp[0 * 33], sp[1 * 33]); o.y = cvt_pk_bf16(sp[2 * 33], sp[3 * 33]); o.z = cvt_pk_bf16(sp[4 * 33], sp[5 * 33]); o.w = cvt_pk_bf16(sp[6 * 33], sp[7 * 33]);
        *(u32x4*)(out + (size_t)(orow0 + n) * ldo + ocol0 + 8 * c) = o; }
    asm volatile("s_waitcnt lgkmcnt(0)" ::: "memory");
}

__device__ __forceinline__ void weight_item(const Args& a, int it, LAS float* scr, int lane) {
    unsigned char* ws = a.ws;
    constexpr int I_W1 = 16 * 96, I_W2A = 8 * 32, I_W3 = 16 * 32, I_W4 = 16 * 176;
    int r = it;
    if (r < I_W1) { const float* W = a.in[7]; const int kb = r / 96, nb = r % 96, n0 = nb * 32;
        const int src0 = n0 < 1024 ? n0 : 1024 + (((n0 - 1024) >> 7) & 1) * 1024 + ((n0 - 1024) >> 8) * 128 + (n0 & 127);
        wave_transpose([=](int k, int n) { return __builtin_nontemporal_load((const f32x4*)(W + (size_t)k * 3072 + n)); }, (bf16_t*)(ws + WS_W1T), 1024, kb * 64, src0, kb * 64, n0, scr, lane); return; }
    r -= I_W1;
    if (r < I_W2A) { const float* W = a.in[8]; const int kb = r >> 5, nb = r & 31;
        wave_transpose([=](int k, int n) { return __builtin_nontemporal_load((const f32x4*)(W + (size_t)k * 1024 + n)); }, (bf16_t*)(ws + WS_W2T), 1024, kb * 64, nb * 32, kb * 64, nb * 32, scr, lane); return; }
    r -= I_W2A;
    if (r < I_W3) { const float* W = a.in[12]; const int kb = r >> 5, nb = r & 31;
        wave_transpose([=](int k, int n) { return __builtin_nontemporal_load((const f32x4*)(W + (size_t)k * 1024 + n)); }, (bf16_t*)(ws + WS_W3T), 1024, kb * 64, nb * 32, kb * 64, nb * 32, scr, lane); return; }
    r -= I_W3;
    if (r < I_W4) { const int kb = r / 176, nb = r % 176; const int n0 = nb * 32;
        const int j = n0 >> 8, bj = (n0 >> 7) & 1, cbase = j * 128 + (n0 & 127); const float* W = bj ? a.in[16] : a.in[15];
        wave_transpose([=](int k, int n) { return __builtin_nontemporal_load((const f32x4*)(W + (size_t)k * FF + n)); }, (bf16_t*)(ws + WS_W4T), 1024, kb * 64, cbase, kb * 64, n0, scr, lane); return; }
    r -= I_W4;
    { const float* W = a.in[17]; const int kb = r >> 5, nb = r & 31;
        wave_transpose([=](int k, int n) { return __builtin_nontemporal_load((const f32x4*)(W + (size_t)k * 1024 + n)); }, (bf16_t*)(ws + WS_W5T), FF, kb * 64, nb * 32, kb * 64, nb * 32, scr, lane); }
}
constexpr int N_WEIGHT_ITEMS = 16 * 96 + 8 * 32 + 16 * 32 + 16 * 176 + 44 * 32;

__device__ __forceinline__ void phase_prep(const Args& a, LAS unsigned char* lds, int G) {
    unsigned char* ws = a.ws;
    const int tid = threadIdx.x, lane = tid & 63, wave = tid >> 6;
    {
        const int gt = blockIdx.x * NTHR + tid, NG = G * NTHR;
        float2* ROOT = (float2*)(ws + WS_ROOT);
        for (int j = gt; j < 16384; j += NG) { float s, c; sincospif((float)j * (1.f / 8192.f), &s, &c); ROOT[j] = make_float2(c, s); }
        _Float16* FC = (_Float16*)(ws + WS_FC); _Float16* FS = FC + 128 * FT_LD;
        for (int j = gt; j < 128 * FT_LD; j += NG) { const int n = j / FT_LD, k = j % FT_LD; float s = 0.f, c = 0.f;
            if (k < 128) { sincospif((float)((n * k) & 127) * (1.f / 64.f), &s, &c); s *= 0.08838834764831845f; c *= 0.08838834764831845f; }
            FC[j] = (_Float16)c; FS[j] = (_Float16)s; }
    }
    LAS float* scr = (LAS float*)lds;
    constexpr int I_ADA = 192;
    for (int it = blockIdx.x; it < I_ADA; it += G) {
        const int e0 = it * 32; const float* cp = a.in[2]; const float* cs = a.in[3]; const float* wada = a.in[4]; const float* bada = a.in[5];
        LAS float* sc = scr;
        LAS float* red = scr + NB * 1024;
        for (int j = tid; j < NB * 1024; j += NTHR) { const float v = (j < 2048) ? cp[j] : cs[j - 2048]; sc[j] = v / (1.f + expf(-v)); }
        __syncthreads();
        const int col = tid & 31, dg = tid >> 5; float accv[NB];
#pragma unroll
        for (int q = 0; q < NB; ++q) accv[q] = 0.f;
        for (int d0 = dg * 64; d0 < dg * 64 + 64; d0 += 16) { float wv[16];
#pragma unroll
            for (int u = 0; u < 16; ++u) wv[u] = __builtin_nontemporal_load(wada + (size_t)(d0 + u) * NADA + e0 + col);
#pragma unroll
            for (int u = 0; u < 16; ++u)
#pragma unroll
                for (int q = 0; q < NB; ++q) accv[q] += sc[q * 1024 + d0 + u] * wv[u]; }
#pragma unroll
        for (int q = 0; q < NB; ++q) red[(dg * NB + q) * 32 + col] = accv[q];
        __syncthreads();
        if (tid < NB * 32) { const int q = tid >> 5, cc = tid & 31; float s = bada[e0 + cc];
            for (int k = 0; k < 16; ++k) s += red[(k * NB + q) * 32 + cc];
            ((float*)(ws + WS_ADA))[q * NADA + e0 + cc] = s; }
        __syncthreads();
    }
    __syncthreads();
    LAS float* wscr = scr + wave * (64 * 33);
    const int gw = (int)blockIdx.x * NWAVES + wave, NW = G * NWAVES;
    for (int r = gw; r < 2048; r += NW) {
        const int k0 = (r >> 5) * 8, n0 = (r & 31) * 32, k = k0 + (lane >> 3), n = n0 + 4 * (lane & 7), gb = k & ~127;
        const float* pg = a.in[9] + (size_t)k * 128; const float* ps = a.in[10] + gb; const float* wpo = a.in[11] + (size_t)gb * 1024 + n;
        f32x4 s4 = {0.f, 0.f, 0.f, 0.f};
#pragma unroll 8
        for (int d = 0; d < 128; ++d) { const float c = pg[d] * ps[d]; const f32x4 wv = *(const f32x4*)(wpo + (size_t)d * 1024); s4 += wv * c; }
        LAS float* dd = wscr + (lane >> 3) * 33 + 4 * (lane & 7); dd[0] = s4.x; dd[1] = s4.y; dd[2] = s4.z; dd[3] = s4.w;
        asm volatile("s_waitcnt lgkmcnt(0)" ::: "memory");
        if (lane < 32) { const LAS float* sp = wscr + lane;
            u32x4 o; o.x = cvt_pk_bf16(sp[0 * 33], sp[1 * 33]); o.y = cvt_pk_bf16(sp[2 * 33], sp[3 * 33]); o.z = cvt_pk_bf16(sp[4 * 33], sp[5 * 33]); o.w = cvt_pk_bf16(sp[6 * 33], sp[7 * 33]);
            *(u32x4*)((bf16_t*)(ws + WS_W2T) + (size_t)(n0 + lane) * 1024 + 512 + k0) = o; }
        asm volatile("s_waitcnt lgkmcnt(0)" ::: "memory");
    }
    if (G == 256) {
        constexpr int NEXTRA = 2048;
        if (blockIdx.x >= I_ADA) for (int it = ((int)blockIdx.x - I_ADA) * NWAVES + wave; it < NEXTRA; it += 64 * NWAVES) weight_item(a, it, wscr, lane);
        for (int it = NEXTRA + gw; it < N_WEIGHT_ITEMS; it += NW) weight_item(a, it, wscr, lane);
    } else {
        for (int it = gw; it < N_WEIGHT_ITEMS; it += NW) weight_item(a, it, wscr, lane);
    }
}

__device__ __forceinline__ const float* xrow_ptr(const Args& a, int t) { return t < TP ? a.in[0] + (size_t)t * D : a.in[1] + (size_t)(t - TP) * D; }

template <int R>
__device__ __forceinline__ void phase_norm1(const Args& a, int G) {
    const int lane = threadIdx.x & 63, wave = threadIdx.x >> 6, gw = blockIdx.x * NWAVES + wave, NW = G * NWAVES;
    const float* ada = (const float*)(a.ws + WS_ADA); bf16_t* H = (bf16_t*)(a.ws + WS_H); const float* gpre = a.in[6];
    f32x4 gp[4];
#pragma unroll
    for (int j = 0; j < 4; ++j) gp[j] = ((const f32x4*)gpre + lane)[64 * j];
    for (int t0 = gw; t0 < T; t0 += R * NW) {
        f32x4 v[R][4], sc[R][4], sh[R][4];
#pragma unroll
        for (int k = 0; k < R; ++k) { const int t = t0 + k * NW; if (t < T) { int r, tb, S; tok_info(t, r, tb, S);
            const f32x4* xr = (const f32x4*)xrow_ptr(a, t) + lane; const f32x4* shp = (const f32x4*)(ada + (size_t)r * NADA) + lane; const f32x4* scp = (const f32x4*)(ada + (size_t)r * NADA + D) + lane;
#pragma unroll
            for (int j = 0; j < 4; ++j) { v[k][j] = __builtin_nontemporal_load(xr + 64 * j); sc[k][j] = scp[64 * j]; sh[k][j] = shp[64 * j]; } } }
#pragma unroll
        for (int k = 0; k < R; ++k) { const int t = t0 + k * NW; if (t < T) { float s = 0.f;
#pragma unroll
            for (int j = 0; j < 4; ++j) s += (v[k][j].x * v[k][j].x + v[k][j].y * v[k][j].y) + (v[k][j].z * v[k][j].z + v[k][j].w * v[k][j].w);
            const float rs = rsqrtf(wave_sum(s) * (1.f / D) + EPS);
            u32x2* o = (u32x2*)(H + (size_t)t * D) + lane;
#pragma unroll
            for (int j = 0; j < 4; ++j) { const f32x4 g = gp[j], c = sc[k][j], h = sh[k][j], x = v[k][j]; f32x4 y;
                y.x = x.x * rs * g.x * (1.f + c.x) + h.x; y.y = x.y * rs * g.y * (1.f + c.y) + h.y; y.z = x.z * rs * g.z * (1.f + c.z) + h.z; y.w = x.w * rs * g.w * (1.f + c.w) + h.w;
                u32x2 w; w.x = cvt_pk_bf16(y.x, y.y); w.y = cvt_pk_bf16(y.z, y.w); o[64 * j] = w; } } }
    }
}
template <int R>
__device__ __forceinline__ void phase_mid(const Args& a, int G) {
    const int lane = threadIdx.x & 63, wave = threadIdx.x >> 6, gw = blockIdx.x * NWAVES + wave, NW = G * NWAVES;
    const float* ada = (const float*)(a.ws + WS_ADA); bf16_t* H = (bf16_t*)(a.ws + WS_H); const bf16_t* MB = (const bf16_t*)(a.ws + WS_MBUF);
    const float* ss1 = (const float*)(a.ws + WS_SS1); const float* gpost = a.in[13]; const float* gpre = a.in[14];
    f32x4 gq[4], gp2[4];
#pragma unroll
    for (int j = 0; j < 4; ++j) { gq[j] = ((const f32x4*)gpost + lane)[64 * j]; gp2[j] = ((const f32x4*)gpre + lane)[64 * j]; }
    for (int t0 = gw; t0 < T; t0 += R * NW) {
        f32x4 v[R][4], g1[R][4]; u32x2 mw[R][4]; float sp[R];
#pragma unroll
        for (int k = 0; k < R; ++k) { const int t = t0 + k * NW; if (t < T) { int r, tb, S; tok_info(t, r, tb, S);
            const f32x4* xr = (const f32x4*)xrow_ptr(a, t) + lane; const u32x2* mr = (const u32x2*)(MB + (size_t)t * D) + lane; const f32x4* gt = (const f32x4*)(ada + (size_t)r * NADA + 2 * D) + lane;
            sp[k] = ss1[(size_t)t * 16 + (lane & 15)];
#pragma unroll
            for (int j = 0; j < 4; ++j) { v[k][j] = __builtin_nontemporal_load(xr + 64 * j); mw[k][j] = __builtin_nontemporal_load(mr + 64 * j); g1[k][j] = gt[64 * j]; } } }
#pragma unroll
        for (int k = 0; k < R; ++k) { const int t = t0 + k * NW; if (t < T) { int r, tb, S; tok_info(t, r, tb, S);
            const f32x4* shp = (const f32x4*)(ada + (size_t)r * NADA + 3 * D) + lane; const f32x4* scp = (const f32x4*)(ada + (size_t)r * NADA + 4 * D) + lane;
            f32x4 sh[4], sc[4];
#pragma unroll
            for (int j = 0; j < 4; ++j) { sh[j] = shp[64 * j]; sc[j] = scp[64 * j]; }
            float q = sp[k]; q += __shfl_xor(q, 1); q += __shfl_xor(q, 2); q += __shfl_xor(q, 4); q += __shfl_xor(q, 8);
            const float rs1 = rsqrtf(q * (1.f / D) + EPS); float s = 0.f;
#pragma unroll
            for (int j = 0; j < 4; ++j) { f32x4 x = v[k][j]; const f32x4 gg = g1[k][j], gp = gq[j]; const u32x2 m = mw[k][j];
                x.x += gg.x * (bf_lo(m.x) * rs1 * gp.x); x.y += gg.y * (bf_hi(m.x) * rs1 * gp.y); x.z += gg.z * (bf_lo(m.y) * rs1 * gp.z); x.w += gg.w * (bf_hi(m.y) * rs1 * gp.w);
                v[k][j] = x; s += (x.x * x.x + x.y * x.y) + (x.z * x.z + x.w * x.w); }
            const float rs = rsqrtf(wave_sum(s) * (1.f / D) + EPS);
            f32x4* xo = (f32x4*)(a.out + (size_t)t * D) + lane; u32x2* o = (u32x2*)(H + (size_t)t * D) + lane;
#pragma unroll
            for (int j = 0; j < 4; ++j) { const f32x4 x = v[k][j];
                if (G == 256) { u32x2 xb; xb.x = cvt_pk_bf16(x.x, x.y); xb.y = cvt_pk_bf16(x.z, x.w); __builtin_nontemporal_store(xb, (u32x2*)((bf16_t*)(a.ws + WS_X1B) + (size_t)t * D) + lane + 64 * j); }
                else __builtin_nontemporal_store(x, xo + 64 * j);
                const f32x4 g = gp2[j], c = sc[j], h = sh[j]; f32x4 y;
                y.x = x.x * rs * g.x * (1.f + c.x) + h.x; y.y = x.y * rs * g.y * (1.f + c.y) + h.y; y.z = x.z * rs * g.z * (1.f + c.z) + h.z; y.w = x.w * rs * g.w * (1.f + c.w) + h.w;
                u32x2 w; w.x = cvt_pk_bf16(y.x, y.y); w.y = cvt_pk_bf16(y.z, y.w); o[64 * j] = w; } } }
    }
}
template <int R>
__device__ __forceinline__ void phase_final(const Args& a, int G) {
    const int lane = threadIdx.x & 63, wave = threadIdx.x >> 6, gw = blockIdx.x * NWAVES + wave, NW = G * NWAVES;
    const float* ada = (const float*)(a.ws + WS_ADA); const bf16_t* ZB = (const bf16_t*)(a.ws + WS_ZBUF);
    const float* ss2 = (const float*)(a.ws + WS_SS2); const float* gpost = a.in[18];
    f32x4 gq[4];
#pragma unroll
    for (int j = 0; j < 4; ++j) gq[j] = ((const f32x4*)gpost + lane)[64 * j];
    for (int t0 = gw; t0 < T; t0 += R * NW) {
        f32x4 v[R][4], g2[R][4]; u32x2 zw[R][4]; float sp[R];
#pragma unroll
        for (int k = 0; k < R; ++k) { const int t = t0 + k * NW; if (t < T) { int r, tb, S; tok_info(t, r, tb, S);
            const f32x4* xr = (const f32x4*)(a.out + (size_t)t * D) + lane; const u32x2* zr = (const u32x2*)(ZB + (size_t)t * D) + lane; const f32x4* gt = (const f32x4*)(ada + (size_t)r * NADA + 5 * D) + lane;
            sp[k] = ss2[(size_t)t * 16 + (lane & 15)];
#pragma unroll
            for (int j = 0; j < 4; ++j) { v[k][j] = xr[64 * j]; zw[k][j] = zr[64 * j]; g2[k][j] = gt[64 * j]; } } }
#pragma unroll
        for (int k = 0; k < R; ++k) { const int t = t0 + k * NW; if (t < T) {
            float q = sp[k]; q += __shfl_xor(q, 1); q += __shfl_xor(q, 2); q += __shfl_xor(q, 4); q += __shfl_xor(q, 8);
            const float rs2 = rsqrtf(q * (1.f / D) + EPS);
            f32x4* xo = (f32x4*)(a.out + (size_t)t * D) + lane;
#pragma unroll
            for (int j = 0; j < 4; ++j) { f32x4 x = v[k][j]; const f32x4 gg = g2[k][j], gp = gq[j]; const u32x2 z = zw[k][j];
                x.x += gg.x * (bf_lo(z.x) * rs2 * gp.x); x.y += gg.y * (bf_hi(z.x) * rs2 * gp.y); x.z += gg.z * (bf_lo(z.y) * rs2 * gp.z); x.w += gg.w * (bf_hi(z.y) * rs2 * gp.w);
                xo[64 * j] = x; } } }
    }
}
template <int W>
__device__ __forceinline__ void pool_task(const bf16_t* UP, bf16_t* A2, int t0, int g, int lane) {
    constexpr int L = W / 2, NR = 32 + W - 1;
    int r, tb, S; tok_info(t0, r, tb, S);
    const int s0 = t0 - tb;
    unsigned row[NR];
#pragma unroll
    for (int j = 0; j < NR; ++j) { const int p = s0 - L + j; row[j] = (p >= 0 && p < S) ? __builtin_nontemporal_load((const unsigned*)(UP + (size_t)(tb + p) * 512 + g * 128) + lane) : 0u; }
    float slo = 0.f, shi = 0.f;
#pragma unroll
    for (int j = 0; j < W - 1; ++j) { slo += bf_lo(row[j]); shi += bf_hi(row[j]); }
#pragma unroll
    for (int i = 0; i < 32; ++i) {
        slo += bf_lo(row[i + W - 1]); shi += bf_hi(row[i + W - 1]);
        const int s = s0 + i, lo = max(s - L, 0), hi = min(s + (W - 1 - L), S - 1); const float inv = __builtin_amdgcn_rcpf((float)(hi - lo + 1));
        *((unsigned*)(A2 + (size_t)(t0 + i) * 1024 + 512 + g * 128) + lane) = cvt_pk_bf16(slo * inv - bf_lo(row[i + L]), shi * inv - bf_hi(row[i + L]));
        slo -= bf_lo(row[i]); shi -= bf_hi(row[i]);
    }
}
__device__ __forceinline__ void phase_pool(const Args& a, int G) {
    const int lane = threadIdx.x & 63, wave = __builtin_amdgcn_readfirstlane(threadIdx.x >> 6), gw = blockIdx.x * NWAVES + wave, NW = G * NWAVES;
    const bf16_t* UP = (const bf16_t*)(a.ws + WS_UP); bf16_t* A2 = (bf16_t*)(a.ws + WS_A2);
    int k = 0;
    for (int task = gw; task < (T / 32) * 4; task += NW, ++k) {
        const int chunk = task >> 2, g = (task + k) & 3, t0 = chunk * 32;
        if (g == 0) pool_task<2>(UP, A2, t0, 0, lane); else if (g == 1) pool_task<4>(UP, A2, t0, 1, lane); else if (g == 2) pool_task<8>(UP, A2, t0, 2, lane); else pool_task<16>(UP, A2, t0, 3, lane);
    }
}

__device__ __forceinline__ void fft_load_tables(const Args& a, LAS unsigned char* lds) {
    const u32x4* src = (const u32x4*)(a.ws + WS_FC); LAS u32x4* dst = (LAS u32x4*)lds;
    for (int i = threadIdx.x; i < 2 * FT_BYTES / 16; i += NTHR) dst[i] = src[i];
    __syncthreads();
}
__device__ __forceinline__ half8 pack_acc(const f32x4 lo, const f32x4 hi) {
    half8 h; h[0] = (_Float16)lo[0]; h[1] = (_Float16)lo[1]; h[2] = (_Float16)lo[2]; h[3] = (_Float16)lo[3]; h[4] = (_Float16)hi[0]; h[5] = (_Float16)hi[1]; h[6] = (_Float16)hi[2]; h[7] = (_Float16)hi[3]; return h;
}
__device__ __forceinline__ half8 neg_h8(half8 v) { u32x4 u = __builtin_bit_cast(u32x4, v); u.x ^= 0x80008000u; u.y ^= 0x80008000u; u.z ^= 0x80008000u; u.w ^= 0x80008000u; return __builtin_bit_cast(half8, u); }
__device__ __forceinline__ half8 tab_frag(const LAS _Float16* tab, int row, int t, int q) {
    const LAS _Float16* p = tab + row * FT_LD + 32 * t + 4 * q; const half4 c0 = *(const LAS half4*)p, c1 = *(const LAS half4*)(p + 16);
    half8 h; h[0] = c0[0]; h[1] = c0[1]; h[2] = c0[2]; h[3] = c0[3]; h[4] = c1[0]; h[5] = c1[1]; h[6] = c1[2]; h[7] = c1[3]; return h;
}
#define MFMA_H(a, b, c) __builtin_amdgcn_mfma_f32_16x16x32_f16(a, b, c, 0, 0, 0)

struct ItemA { int g, s2, N2, tb, rmul; };
__device__ __forceinline__ ItemA decode_a(int it) {
    ItemA I;
    if (it < 1024) { const int b = it >> 9; I.g = (it >> 7) & 3; I.s2 = it & 127; I.N2 = 128; I.tb = b << 14; I.rmul = 1; }
    else { const int j = it - 1024, b = j >> 6; I.g = (j >> 4) & 3; I.s2 = j & 15; I.N2 = 16; I.tb = TP + (b << 11); I.rmul = 8; }
    return I;
}
__device__ __forceinline__ void fft_pass_a(const Args& a, LAS unsigned char* lds, int G) {
    const LAS _Float16* FC = (const LAS _Float16*)lds; const LAS _Float16* FS = FC + 128 * FT_LD;
    const int lane = threadIdx.x & 63, w = __builtin_amdgcn_readfirstlane(threadIdx.x >> 6), r = lane & 15, q = lane >> 4;
    const _Float16* UF = (const _Float16*)(a.ws + WS_UF); _Float16* T2 = (_Float16*)(a.ws + WS_H); const float2* ROOT = (const float2*)(a.ws + WS_ROOT);
    LAS _Float16* OT = (LAS _Float16*)(lds + 2 * FT_BYTES); constexpr int OTA_LD = 264;
    LAS f32x2_t* TW = (LAS f32x2_t*)(lds + 2 * FT_BYTES + 128 * OTA_LD * 2);
    f32x2_t twn = {1.f, 0.f};
    half8 U[8][4];
#define PA_LOAD(itx, R0) do { const ItemA J = decode_a(itx); const _Float16* ub = UF + (size_t)(J.tb + J.s2) * 512 + J.g * 128 + q * 8; \
        _Pragma("unroll") for (int rt = R0; rt < R0 + 4; ++rt) { const _Float16* p = ub + (size_t)(16 * rt + r) * J.N2 * 512; \
            _Pragma("unroll") for (int t = 0; t < 4; ++t) U[rt][t] = *(const half8*)(p + 32 * t); } } while (0)
    int it = blockIdx.x;
    if (it < 1536) { PA_LOAD(it, 0); if (threadIdx.x < 128) { const ItemA J = decode_a(it); { const float2 c_ = ROOT[(J.s2 * (int)threadIdx.x * J.rmul) & 16383]; twn = (f32x2_t){c_.x, c_.y}; } } }
    for (; it < 1536; it += G) {
        const ItemA I = decode_a(it); const int g = I.g, s2 = I.s2, N2 = I.N2, tb = I.tb, rmul = I.rmul;
        PA_LOAD(it, 4);
        if (threadIdx.x < 128) TW[threadIdx.x] = twn;
        half8 ZrB[4], ZiB[4];
        {
            half8 FcB[4], FsB[4];
#pragma unroll
            for (int t = 0; t < 4; ++t) { FcB[t] = *(const LAS half8*)(FC + (16 * w + r) * FT_LD + 32 * t + 8 * q); FsB[t] = *(const LAS half8*)(FS + (16 * w + r) * FT_LD + 32 * t + 8 * q); }
            f32x4 accR[8], accI[8];
#pragma unroll
            for (int rt = 0; rt < 8; ++rt) { f32x4 cr = {0.f, 0.f, 0.f, 0.f}, ci = {0.f, 0.f, 0.f, 0.f};
#pragma unroll
                for (int t = 0; t < 4; ++t) { cr = MFMA_H(U[rt][t], FcB[t], cr); ci = MFMA_H(U[rt][t], FsB[t], ci); }
                accR[rt] = cr; accI[rt] = ci; }
#pragma unroll
            for (int t = 0; t < 4; ++t) { ZrB[t] = pack_acc(accR[2 * t], accR[2 * t + 1]); ZiB[t] = pack_acc(accI[2 * t], accI[2 * t + 1]); }
        }
        if (it + G < 1536) { PA_LOAD(it + G, 0); if (threadIdx.x < 128) { const ItemA J = decode_a(it + G); { const float2 c_ = ROOT[(J.s2 * (int)threadIdx.x * J.rmul) & 16383]; twn = (f32x2_t){c_.x, c_.y}; } } }
        __syncthreads();
#pragma unroll 1
        for (int kt = 0; kt < 5; ++kt) {
            f32x4 P = {0.f, 0.f, 0.f, 0.f}, Q = P, R = P, S = P;
#pragma unroll
            for (int t = 0; t < 4; ++t) { const half8 fc = tab_frag(FC, 16 * kt + r, t, q), fs = tab_frag(FS, 16 * kt + r, t, q);
                P = MFMA_H(fc, ZrB[t], P); Q = MFMA_H(fs, ZiB[t], Q); R = MFMA_H(fc, ZiB[t], R); S = MFMA_H(fs, ZrB[t], S); }
#pragma unroll
            for (int j = 0; j < 4; ++j) { const int k1 = 16 * kt + 4 * q + j;
                if (kt < 4 || k1 == 64) { const f32x2_t cs = TW[k1]; const float Tr = P[j] - Q[j], Tn = R[j] + S[j];
                    LAS _Float16* o = OT + k1 * OTA_LD + 16 * w + r; o[0] = (_Float16)(Tr * cs.x - Tn * cs.y); o[128] = (_Float16)(-(Tn * cs.x + Tr * cs.y)); }
                if (kt < 4 && k1 != 0) { const int mk = 128 - k1; const f32x2_t cs = TW[mk]; const float Tr = P[j] + Q[j], Tn = R[j] - S[j];
                    LAS _Float16* o = OT + mk * OTA_LD + 16 * w + r; o[0] = (_Float16)(Tr * cs.x - Tn * cs.y); o[128] = (_Float16)(-(Tn * cs.x + Tr * cs.y)); } }
        }
        __syncthreads();
        {
            _Float16* dst = T2 + (size_t)tb * 1024 + (size_t)(g * 128) * N2 * 256 + (size_t)s2 * 256;
#pragma unroll
            for (int i = 0; i < 8; ++i) { const int c = threadIdx.x + i * NTHR, k1 = c >> 5, within = c & 31;
                const u32x4 vv = *(const LAS u32x4*)((const LAS unsigned char*)OT + k1 * (OTA_LD * 2) + within * 16);
                *(u32x4*)(dst + (size_t)k1 * N2 * 256 + within * 8) = vv; }
        }
    }
#undef PA_LOAD
}
__device__ __forceinline__ void fft_pass_b(const Args& a, LAS unsigned char* lds, int G) {
    const LAS _Float16* FC = (const LAS _Float16*)lds; const LAS _Float16* FS = FC + 128 * FT_LD;
    LAS bf16_t* OT = (LAS bf16_t*)(lds + 2 * FT_BYTES); constexpr int OTB_LD = 136;
    const int lane = threadIdx.x & 63, w = __builtin_amdgcn_readfirstlane(threadIdx.x >> 6), r = lane & 15, q = lane >> 4;
    const _Float16* T2 = (const _Float16*)(a.ws + WS_H); bf16_t* A2 = (bf16_t*)(a.ws + WS_A2); const float2* ROOT = (const float2*)(a.ws + WS_ROOT);
    half8 Sel, A16;
#pragma unroll
    for (int jj = 0; jj < 8; ++jj) { Sel[jj] = (8 * q + jj == 16 * (w & 1) + r) ? (_Float16)1.f : (_Float16)0.f;
        const int s2 = 4 * q + (jj & 3); const float2 cs = ROOT[((r * s2) & 15) * 1024]; A16[jj] = (_Float16)(0.25f * (jj < 4 ? cs.x : cs.y)); }
    const f32x4 zero = {0.f, 0.f, 0.f, 0.f};
    {
        half8 Lr[8], Li[8];
#define PB_LOAD(itx) do { const int b_ = (itx) >> 9, g_ = ((itx) >> 7) & 3, k1_ = (itx) & 127; \
        const _Float16* base_ = T2 + (size_t)(b_ << 14) * 1024 + (size_t)(g_ * 128 + k1_) * 128 * 256 + 32 * (w >> 1) + 8 * q; \
        _Pragma("unroll") for (int rt = 0; rt < 8; ++rt) { const _Float16* p = base_ + (16 * rt + r) * 256; Lr[rt] = *(const half8*)p; Li[rt] = *(const half8*)(p + 128); } } while (0)
        int it = blockIdx.x;
        if (it < 1024) PB_LOAD(it);
        for (; it < 1024; it += G) {
            const int b = it >> 9, g = (it >> 7) & 3, k1 = it & 127, tb = b << 14;
            half8 RB[4], IB[4];
            {
                f32x4 Dr[8], Di[8];
#pragma unroll
                for (int rt = 0; rt < 8; ++rt) { Dr[rt] = MFMA_H(Lr[rt], Sel, zero); Di[rt] = MFMA_H(Li[rt], Sel, zero); }
#pragma unroll
                for (int t = 0; t < 4; ++t) { RB[t] = pack_acc(Dr[2 * t], Dr[2 * t + 1]); IB[t] = pack_acc(Di[2 * t], Di[2 * t + 1]); }
            }
            if (it + G < 1024) PB_LOAD(it + G);
            __syncthreads();
#pragma unroll 1
            for (int kt = 0; kt < 5; ++kt) {
                f32x4 C = zero, Dd = zero;
#pragma unroll
                for (int t = 0; t < 4; ++t) { const half8 fc = tab_frag(FC, 16 * kt + r, t, q), fs = tab_frag(FS, 16 * kt + r, t, q);
                    C = MFMA_H(fc, RB[t], C); Dd = MFMA_H(fs, IB[t], Dd); }
#pragma unroll
                for (int j = 0; j < 4; ++j) { const int k2 = 16 * kt + 4 * q + j;
                    if (kt < 4 || k2 == 64) { const float y = C[j] + Dd[j]; OT[k2 * OTB_LD + 16 * w + r] = (bf16_t)(cvt_pk_bf16(y, y) & 0xffffu); }
                    if (kt < 4 && k2 != 0) { const float y = C[j] - Dd[j]; OT[(128 - k2) * OTB_LD + 16 * w + r] = (bf16_t)(cvt_pk_bf16(y, y) & 0xffffu); } }
            }
            __syncthreads();
            bf16_t* dst = A2 + (size_t)(tb + k1) * 1024 + g * 128;
#pragma unroll
            for (int i = 0; i < 4; ++i) { const int c = threadIdx.x + i * NTHR, k2 = c >> 4, ch = c & 15;
                const u32x4 vv = *(const LAS u32x4*)((const LAS unsigned char*)OT + k2 * (OTB_LD * 2) + ch * 16);
                *(u32x4*)(dst + (size_t)k2 * 128 * 1024 + ch * 8) = vv; }
        }
#undef PB_LOAD
    }
    for (int it0 = blockIdx.x; it0 < 4096; it0 += 4 * G) {
        half8 ar[4], ai[4];
#pragma unroll
        for (int u = 0; u < 4; ++u) { const int j = it0 + u * G; if (j < 4096) { const int b = j >> 9, g = (j >> 7) & 3, k1 = j & 127, tb = TP + (b << 11);
            const _Float16* p = T2 + (size_t)tb * 1024 + (size_t)(g * 128 + k1) * 16 * 256 + 32 * (w >> 1) + 8 * q + r * 256;
            ar[u] = *(const half8*)p; ai[u] = *(const half8*)(p + 128); } }
        __syncthreads();
#pragma unroll
        for (int u = 0; u < 4; ++u) { const int j = it0 + u * G; if (j < 4096) {
            const f32x4 Dr = MFMA_H(ar[u], Sel, zero), Di = MFMA_H(ai[u], Sel, zero);
            const half8 Bf = pack_acc(Dr, Di);
            const f32x4 Y = MFMA_H(A16, Bf, zero);
#pragma unroll
            for (int jj = 0; jj < 4; ++jj) { const int k2 = 4 * q + jj; OT[(u * 16 + k2) * OTB_LD + 16 * w + r] = (bf16_t)(cvt_pk_bf16(Y[jj], Y[jj]) & 0xffffu); } } }
        __syncthreads();
#pragma unroll
        for (int i = 0; i < 2; ++i) { const int c = threadIdx.x + i * NTHR, row = c >> 4, ch = c & 15, u = row >> 4, k2 = row & 15; const int j = it0 + u * G;
            if (j < 4096) { const int b = j >> 9, g = (j >> 7) & 3, k1 = j & 127, tb = TP + (b << 11);
                const u32x4 vv = *(const LAS u32x4*)((const LAS unsigned char*)OT + row * (OTB_LD * 2) + ch * 16);
                *(u32x4*)(A2 + (size_t)(tb + k1 + 128 * k2) * 1024 + g * 128 + ch * 8) = vv; } }
    }
}

#define XB_TMO      128
#define XB_XCNT(j)  (256  + 64 * (j))
#define XB_XSUB(j)  (1280 + 64 * (j))
#define XB_XGEN(j)  (2304 + 64 * (j))
#define XB_TOP      3328
#define XB_TOPGEN   3392
#define XCD_BAR_WORDS 3456
#define XB_SPIN_CAP (1u << 18)
__device__ __forceinline__ unsigned xb_ld(unsigned* p)              { return __hip_atomic_load(p, __ATOMIC_RELAXED, __HIP_MEMORY_SCOPE_AGENT); }
__device__ __forceinline__ unsigned xb_add(unsigned* p, unsigned v) { return __hip_atomic_fetch_add(p, v, __ATOMIC_RELAXED, __HIP_MEMORY_SCOPE_AGENT); }
__device__ __forceinline__ unsigned xb_xcc_id() { return (unsigned)__builtin_amdgcn_s_getreg((3 << 11) | 20) & 0xFu; }
#define XB_SPIN(cond, bar) do { unsigned _sp = 0; while (cond) { __builtin_amdgcn_s_sleep(1); \
    if ((++_sp & 255u) == 0u) { if (xb_ld(&(bar)[XB_TMO])) break; if (_sp > XB_SPIN_CAP) { atomicAdd(&(bar)[XB_TMO], 1u); break; } } } } while (0)
struct XcdBarrier { unsigned* bar; unsigned x; volatile LAS unsigned* st; };
__device__ __forceinline__ XcdBarrier xcd_barrier_post(unsigned* bar, volatile LAS unsigned* st) {
    XcdBarrier b; b.bar = bar; b.x = xb_xcc_id(); b.st = st;
    if (threadIdx.x == 0) (void)xb_add(&bar[XB_XCNT(b.x)], 1u);
    return b;
}
__device__ __forceinline__ void xcd_barrier_complete(unsigned* bar, unsigned x, unsigned& nloc, unsigned& nx) {
    const unsigned G = gridDim.x * gridDim.y * gridDim.z;
    unsigned sum, cnt, mine, sp = 0u;
    for (;;) {
        sum = 0u; cnt = 0u; mine = 0u;
#pragma unroll
        for (unsigned j = 0; j < 16; ++j) { const unsigned c = xb_ld(&bar[XB_XCNT(j)]); sum += c; cnt += (c > 0u) ? 1u : 0u; mine = (j == x) ? c : mine; }
        if (sum == G) break;
        __builtin_amdgcn_s_sleep(1);
        if ((++sp & 255u) == 0u) { if (xb_ld(&bar[XB_TMO])) break; if (sp > XB_SPIN_CAP) { atomicAdd(&bar[XB_TMO], 1u); break; } }
    }
    nloc = mine > 0u ? mine : 1u; nx = cnt > 0u ? cnt : 1u;
}
__device__ __forceinline__ void xcd_barrier(const XcdBarrier& b) {
    asm volatile("s_waitcnt vmcnt(0)" ::: "memory");
    __syncthreads();
    if (threadIdx.x == 0) {
        unsigned* bar = b.bar;
        __builtin_amdgcn_s_waitcnt(0);
        unsigned nloc = b.st[0], nx = b.st[1];
        if (nloc == 0u) { xcd_barrier_complete(bar, b.x, nloc, nx); b.st[0] = nloc; b.st[1] = nx; }
        const unsigned old = xb_add(&bar[XB_XSUB(b.x)], 1u);
        const unsigned gen = old / nloc;
        if (old + 1u == (gen + 1u) * nloc) {
            __builtin_amdgcn_fence(__ATOMIC_RELEASE, "agent");
            asm volatile("s_waitcnt vmcnt(0)" ::: "memory");
            const unsigned og = xb_add(&bar[XB_TOP], 1u);
            const unsigned tg = og / nx;
            if (og + 1u == (tg + 1u) * nx) xb_add(&bar[XB_TOPGEN], 1u);
            else XB_SPIN(xb_ld(&bar[XB_TOPGEN]) == tg, bar);
            __builtin_amdgcn_fence(__ATOMIC_ACQUIRE, "agent");
            xb_add(&bar[XB_XGEN(b.x)], 1u);
            asm volatile("s_waitcnt vmcnt(0)" ::: "memory");
        } else {
            XB_SPIN(xb_ld(&bar[XB_XGEN(b.x)]) == gen, bar);
            __builtin_amdgcn_fence(__ATOMIC_ACQUIRE, "agent");
            asm volatile("s_waitcnt vmcnt(0)" ::: "memory");
        }
    }
    __syncthreads();
}

__global__ void __launch_bounds__(NTHR, 2) fwd_megakernel(Args a) {
    extern __shared__ __attribute__((aligned(16))) unsigned char lds_raw[];
    LAS unsigned char* lds = (LAS unsigned char*)lds_raw;
    const int G = gridDim.x;
    unsigned char* ws = a.ws;
    volatile LAS unsigned* bst = (volatile LAS unsigned*)(lds + LDS_BYTES - 64);
    if (threadIdx.x == 0) { bst[0] = 0u; bst[1] = 0u; }
    __syncthreads();
    const XcdBarrier xbar = xcd_barrier_post((unsigned*)(ws + WS_BAR), bst);

    phase_prep(a, lds, G);
    xcd_barrier(xbar);
    phase_norm1<4>(a, G);
    xcd_barrier(xbar);
    {
        pg8::Gemm g{(const bf16_t*)(ws + WS_H), (const bf16_t*)(ws + WS_W1T), T, 3072, 1024, 1024, 1024, 0, 0}; pg8::StaticOrder S; S.init(T, 3072, G, (int)blockIdx.x);
        pg8::EpiG1 E{(_Float16*)(ws + WS_UF), (bf16_t*)(ws + WS_UP), (bf16_t*)(ws + WS_GATES)};
        pg8::gemm_phase(lds, g, S, E);
    }
    xcd_barrier(xbar);
    fft_load_tables(a, lds);
    fft_pass_a(a, lds, G);
    phase_pool(a, G);
    xcd_barrier(xbar);
    fft_pass_b(a, lds, G);
    xcd_barrier(xbar);
    {
        pg8::TwoPartOrder S; S.init(T, 1024, G, (int)blockIdx.x);
        pg8::Gemm g{(const bf16_t*)(ws + WS_A2), (const bf16_t*)(ws + WS_W2T), T, 1024, 512, 1024, 1024, 1024, 1024};
        pg8::EpiMix2 E{(bf16_t*)(ws + WS_H), (const bf16_t*)(ws + WS_GATES)};
        pg8::gemm_phase(lds, g, S, E);
    }
    xcd_barrier(xbar);
    {
        pg8::Gemm g{(const bf16_t*)(ws + WS_H), (const bf16_t*)(ws + WS_W3T), T, 1024, 1024, 1024, 1024, 0, 0}; pg8::StaticOrder S; S.init(T, 1024, G, (int)blockIdx.x);
        pg8::EpiRowSS E{(bf16_t*)(ws + WS_MBUF), (float*)(ws + WS_SS1)};
        pg8::gemm_phase(lds, g, S, E);
    }
    xcd_barrier(xbar);
    phase_mid<2>(a, G);
    xcd_barrier(xbar);
    {
        pg8::Gemm g{(const bf16_t*)(ws + WS_H), (const bf16_t*)(ws + WS_W4T), T, 2 * FF, 1024, 1024, 1024, 0, 0}; pg8::StaticOrder S; S.init(T, 2 * FF, G, (int)blockIdx.x);
        pg8::EpiSwiGLU E{(bf16_t*)(ws + WS_SBUF)};
        pg8::gemm_phase(lds, g, S, E);
    }
    xcd_barrier(xbar);
    if (G == 256) {
        pg8::Gemm g{(const bf16_t*)(ws + WS_SBUF), (const bf16_t*)(ws + WS_W5T), T, 1024, FF, FF, FF, 0, 0}; pg8::StaticOrder S; S.init(T, 1024, G, (int)blockIdx.x);
        pg8::EpiFinal E{a.out, (const bf16_t*)(ws + WS_X1B), (const float*)(ws + WS_ADA), a.in[18], (float*)(ws + WS_SSX), (unsigned*)(ws + WS_XCTR), (LAS float*)(lds + 131072)};
        pg8::gemm_phase(lds, g, S, E);
    } else {
        {
            pg8::Gemm g{(const bf16_t*)(ws + WS_SBUF), (const bf16_t*)(ws + WS_W5T), T, 1024, FF, FF, FF, 0, 0}; pg8::StaticOrder S; S.init(T, 1024, G, (int)blockIdx.x);
            pg8::EpiRowSS E{(bf16_t*)(ws + WS_ZBUF), (float*)(ws + WS_SS2)};
            pg8::gemm_phase(lds, g, S, E);
        }
        xcd_barrier(xbar);
        phase_final<4>(a, G);
    }
}

extern "C" void kernel_launch(void* const* d_in, const int* in_sizes, int n_in, void* d_out, int out_size, void* d_ws, size_t ws_size, hipStream_t stream) {
    static int grid = 0;
    if (grid == 0) {
        if (n_in != 19 || out_size != T * D || ws_size < WS_END) { fprintf(stderr, "kernel_launch: unexpected shapes (n_in %d, out %d, ws %zu)\n", n_in, out_size, ws_size); grid = -1; return; }
        int dev = 0, cus = 0, per_cu = 0;
        if (hipGetDevice(&dev) != hipSuccess || hipDeviceGetAttribute(&cus, hipDeviceAttributeMultiprocessorCount, dev) != hipSuccess) { grid = -1; return; }
        if (hipFuncSetAttribute((const void*)fwd_megakernel, hipFuncAttributeMaxDynamicSharedMemorySize, LDS_BYTES) != hipSuccess) { fprintf(stderr, "kernel_launch: hipFuncSetAttribute failed\n"); grid = -1; return; }
        if (hipOccupancyMaxActiveBlocksPerMultiprocessor(&per_cu, (const void*)fwd_megakernel, NTHR, LDS_BYTES) != hipSuccess || per_cu < 1) { fprintf(stderr, "kernel_launch: occupancy query failed (%d)\n", per_cu); (void)hipGetLastError(); grid = -1; return; }
        grid = cus * per_cu;
    }
    if (grid < 0) return;
    if (hipMemsetAsync((char*)d_ws + WS_BAR, 0, WS_MEMSET_BYTES, stream) != hipSuccess) { fprintf(stderr, "kernel_launch: memset failed\n"); return; }
    Args a{};
    for (int i = 0; i < 19; ++i) a.in[i] = (const float*)d_in[i];
    a.out = (float*)d_out; a.ws = (unsigned char*)d_ws;
    void* args[] = {&a};
    hipError_t e = hipLaunchCooperativeKernel((const void*)fwd_megakernel, dim3(grid), dim3(NTHR), args, LDS_BYTES, stream);
    if (e != hipSuccess) fprintf(stderr, "kernel_launch: cooperative launch failed: %s (grid %d)\n", hipGetErrorString(e), grid);
}
```

```cpp
#include <hip/hip_runtime.h>
#include <hip/hip_cooperative_groups.h>
#include <cstdio>
#include <cstdint>
namespace cg = cooperative_groups;

#define LAS __attribute__((address_space(3)))
typedef unsigned short bf16_t;
typedef short bf16x8 __attribute__((ext_vector_type(8)));
typedef _Float16 half8 __attribute__((ext_vector_type(8)));
typedef _Float16 half4 __attribute__((ext_vector_type(4)));
typedef _Float16 half2v __attribute__((ext_vector_type(2)));
typedef float f32x4 __attribute__((ext_vector_type(4)));
typedef unsigned u32x4 __attribute__((ext_vector_type(4)));
typedef unsigned u32x2 __attribute__((ext_vector_type(2)));

constexpr int D = 1024, TP = 2 * 16384, TS = 8 * 2048, T = TP + TS;
constexpr int NB = 10;
constexpr int FF = 2816, NADA = 6 * D;
constexpr float EPS = 1e-6f;
constexpr int NWAVES = 8, NTHR = 512;

constexpr size_t MiB = 1u << 20;
constexpr size_t WS_ADA = 0;
constexpr size_t WS_BAR = 512 * 1024;
constexpr size_t WS_XCTR = 512 * 1024 + 16384;
constexpr size_t WS_MEMSET_BYTES = 16384 + 2 * 192 * 64;
constexpr size_t WS_ROOT = 768 * 1024;
constexpr size_t WS_FC = 1 * MiB;
constexpr int FT_LD = 136, FT_BYTES = 128 * FT_LD * 2;
constexpr size_t WS_W1T = 2 * MiB;
constexpr size_t WS_W2T = 8 * MiB;
constexpr size_t WS_W3T = 10 * MiB;
constexpr size_t WS_W4T = 12 * MiB;
constexpr size_t WS_W5T = 23 * MiB;
constexpr size_t WS_H = 32 * MiB;
constexpr size_t WS_GATES = 128 * MiB;
constexpr size_t WS_UF = 320 * MiB;
constexpr size_t WS_UP = 368 * MiB;
constexpr size_t WS_A2 = 416 * MiB;
constexpr size_t WS_MBUF = 320 * MiB;
constexpr size_t WS_SBUF = 128 * MiB;
constexpr size_t WS_ZBUF = 416 * MiB;
constexpr size_t WS_SS1 = 128 * MiB;
constexpr size_t WS_SS2 = 32 * MiB;
constexpr size_t WS_SSX = 28 * MiB + 512 * 1024;
constexpr size_t WS_X1B = 416 * MiB;
constexpr size_t WS_END = 512 * MiB;

constexpr int LDS_BYTES = 147456;

typedef __bf16 bf16x2_t __attribute__((ext_vector_type(2)));
typedef float f32x2_t __attribute__((ext_vector_type(2)));
__device__ __forceinline__ unsigned cvt_pk_bf16(float lo, float hi) { const f32x2_t v = {lo, hi}; const bf16x2_t b = __builtin_convertvector(v, bf16x2_t); return __builtin_bit_cast(unsigned, b); }
__device__ __forceinline__ unsigned pk_f16(float lo, float hi) { half2v h = {(_Float16)lo, (_Float16)hi}; return __builtin_bit_cast(unsigned, h); }
__device__ __forceinline__ float bf_lo(unsigned w) { return __builtin_bit_cast(float, w << 16); }
__device__ __forceinline__ float bf_hi(unsigned w) { return __builtin_bit_cast(float, w & 0xffff0000u); }
__device__ __forceinline__ float sigmoid_f(float x) { return __builtin_amdgcn_rcpf(1.f + __expf(-x)); }
__device__ __forceinline__ float wave_sum(float v) {
#pragma unroll
    for (int o = 1; o < 64; o <<= 1) v += __shfl_xor(v, o);
    return v;
}
__device__ __forceinline__ void tok_info(int t, int& r, int& tb, int& S) {
    if (t < TP) { r = t >> 14; tb = r << 14; S = 16384; }
    else { const int j = (t - TP) >> 11; r = 2 + j; tb = TP + (j << 11); S = 2048; }
}

namespace pg8 {
constexpr int BM = 256, BK = 64, HALF = 128, HTB = HALF * BK * 2, NXCD = 8, WGM = 8;
__host__ __device__ __forceinline__ int lds_byte(int r, int c) { const int st = (r >> 4) * 2 + (c >> 5), rr = r & 15, cc = c & 31, ob = rr * 64 + cc * 2; return st * 1024 + (ob ^ (((ob >> 9) & 1) << 5)); }
__host__ __device__ __forceinline__ void stage_rc(int b, int& R, int& C) { const int st = b / 1024, sb = b % 1024, swz = sb ^ (((sb >> 9) & 1) << 5); R = (st >> 1) * 16 + swz / 64; C = (st & 1) * 32 + (swz % 64) / 2; }
__host__ __device__ __forceinline__ int perm32(int rho) { const int n = rho >> 4, i = rho & 15; return 8 * (i >> 2) + 4 * n + (i & 3); }

struct Unit { int pm, pn, part; };
struct Gemm { const bf16_t* A; const bf16_t* Bt; int M, N, K, lda, ldb, poffA, poffB; };

struct StaticOrder {
    int nM, nN, nwg, G, c;
    __device__ void init(int M, int N, int G_, int c_) { nM = M / BM; nN = N / BM; nwg = nM * nN; G = G_; c = c_; }
    __device__ bool next(int i, Unit& u) const {
        const long L = (long)i * G + c; if (L >= nwg) return false;
        int wgid = (int)L; { const int q = nwg / NXCD, r = nwg % NXCD, xcd = wgid % NXCD, off = wgid / NXCD; wgid = (xcd < r ? xcd * (q + 1) : r * (q + 1) + (xcd - r) * q) + off; }
        const int nig = WGM * nN, gid = wgid / nig, fm = gid * WGM, gsz = (nM - fm) < WGM ? (nM - fm) : WGM;
        u.pm = fm + ((wgid % nig) % gsz); u.pn = (wgid % nig) / gsz; u.part = 0; return true;
    }
};
struct TwoPartOrder {
    StaticOrder S;
    __device__ void init(int M, int N, int G_, int c_) { S.init(M, N, G_, c_); }
    __device__ bool next(int i, Unit& u) const { if (!S.next(i >> 1, u)) return false; u.part = i & 1; return true; }
};

template <class Epi, class Sched>
__device__ __forceinline__ void gemm_phase(LAS unsigned char* lds, const Gemm g, const Sched& S, const Epi& E) {
    int tid = threadIdx.x; asm volatile("" : "+v"(tid));
    const int wid = __builtin_amdgcn_readfirstlane(tid >> 6), lane = tid & 63, wr = wid >> 2, wc = wid & 3, fr = lane & 15, fq = lane >> 4;
    const int K = g.K, nt = K / BK;
    unsigned voffA[2], voffB[2];
#pragma unroll
    for (int i = 0; i < 2; ++i) { int R, C; stage_rc(tid * 16 + i * 8192, R, C); const int Rb = (R & ~31) + perm32(R & 31);
        voffA[i] = (unsigned)(R * g.lda + C) * 2u; voffB[i] = (unsigned)(Rb * g.ldb + C) * 2u; }
    const size_t kstep = (size_t)(BK * 2);
    const size_t hstepA = (size_t)HALF * g.lda * 2, hstepB = (size_t)HALF * g.ldb * 2;
    const size_t tstepA = 2 * hstepA, tstepB = 2 * hstepB;
    const unsigned ldsw = (unsigned)wid * 1024u;
    const int aoff = lds_byte(wr * 64 + fr, fq * 8), boff = lds_byte(wc * 32 + fr, fq * 8);
#define PG8_SA(b, h) (((b) * 2 + (h)) * HTB)
#define PG8_SB(b, h) ((4 + (b) * 2 + (h)) * HTB)
#define PG8_STAGE(bufoff, gbase, voff) do { _Pragma("unroll") for (int _i = 0; _i < 2; ++_i) \
        __builtin_amdgcn_global_load_lds((const unsigned*)((const char*)(gbase) + (voff)[_i]), (LAS unsigned*)(lds + (bufoff) + ldsw + _i * 8192), 16, 0, 0); } while (0)
#define PG8_LDA(dst, b, h) do { _Pragma("unroll") for (int m = 0; m < 4; ++m) _Pragma("unroll") for (int k = 0; k < 2; ++k) dst[m][k] = *(const LAS bf16x8*)(lds + PG8_SA(b, h) + aoff + m * 2048 + k * 1024); } while (0)
#define PG8_LDB(dst, b, h) do { _Pragma("unroll") for (int n = 0; n < 2; ++n) _Pragma("unroll") for (int k = 0; k < 2; ++k) dst[n][k] = *(const LAS bf16x8*)(lds + PG8_SB(b, h) + boff + n * 2048 + k * 1024); } while (0)
#define PG8_MMA(ai, bj, At, Bt) do { __builtin_amdgcn_s_setprio(1); _Pragma("unroll") for (int m = 0; m < 4; ++m) _Pragma("unroll") for (int n = 0; n < 2; ++n) _Pragma("unroll") for (int k = 0; k < 2; ++k) \
        acc[ai][bj][m][n] = __builtin_amdgcn_mfma_f32_16x16x32_bf16(Bt[n][k], At[m][k], acc[ai][bj][m][n], 0, 0, 0); __builtin_amdgcn_s_setprio(0); } while (0)
#define PG8_WAIT_V(n) asm volatile("s_waitcnt vmcnt(" #n ")" ::: "memory")
#define PG8_WAIT_L(n) asm volatile("s_waitcnt lgkmcnt(" #n ")" ::: "memory")
#define PG8_BAR __builtin_amdgcn_s_barrier()
#define PG8_SCHED __builtin_amdgcn_sched_barrier(0)
    Unit cur, nxt; int ui = 0;
    if (!S.next(0, cur)) return;
    f32x4 acc[2][2][4][2];
#pragma unroll
    for (int a = 0; a < 2; ++a)
#pragma unroll
        for (int b = 0; b < 2; ++b)
#pragma unroll
            for (int m = 0; m < 4; ++m)
#pragma unroll
                for (int n = 0; n < 2; ++n) acc[a][b][m][n] = (f32x4){0.f, 0.f, 0.f, 0.f};
    bf16x8 At[4][2], B0[2][2], B1[2][2];
    const char* cA = (const char*)g.A + (size_t)cur.pm * tstepA + (size_t)cur.part * g.poffA; const char* cB = (const char*)g.Bt + (size_t)cur.pn * tstepB + (size_t)cur.part * g.poffB;
    PG8_STAGE(PG8_SB(0, 0), cB, voffB); PG8_STAGE(PG8_SB(0, 1), cB + hstepB, voffB); PG8_STAGE(PG8_SA(0, 0), cA, voffA); PG8_STAGE(PG8_SA(0, 1), cA + hstepA, voffA);
    if (wr == 1) PG8_BAR;
    PG8_WAIT_V(2); PG8_BAR;
    PG8_STAGE(PG8_SB(1, 0), cB + kstep, voffB); PG8_STAGE(PG8_SA(1, 0), cA + kstep, voffA); PG8_STAGE(PG8_SB(1, 1), cB + hstepB + kstep, voffB);
    PG8_WAIT_V(6); PG8_BAR;
    for (;;) {
        const bool has_next = S.next(ui + 1, nxt);
        const char* nA = has_next ? (const char*)g.A + (size_t)nxt.pm * tstepA + (size_t)nxt.part * g.poffA : cA; const char* nB = has_next ? (const char*)g.Bt + (size_t)nxt.pn * tstepB + (size_t)nxt.part * g.poffB : cB;
        for (int t = 0; t < nt; t += 2) {
            const bool last = (t == nt - 2);
            const char* a1 = cA + (size_t)(t + 1) * kstep;
            const char* a2 = last ? nA : cA + (size_t)(t + 2) * kstep; const char* b2 = last ? nB : cB + (size_t)(t + 2) * kstep;
            const char* a3 = a2 + kstep; const char* b3 = b2 + kstep;
            PG8_LDB(B0, 0, 0); PG8_LDB(B1, 0, 1); PG8_SCHED; PG8_LDA(At, 0, 0); PG8_STAGE(PG8_SA(1, 1), a1 + hstepA, voffA);
            PG8_WAIT_V(8); PG8_WAIT_L(0); PG8_BAR; PG8_MMA(0, 0, At, B0); PG8_MMA(0, 1, At, B1); PG8_BAR; PG8_SCHED;
            PG8_LDA(At, 0, 1); PG8_STAGE(PG8_SB(0, 0), b2, voffB); PG8_STAGE(PG8_SB(0, 1), b2 + hstepB, voffB); PG8_STAGE(PG8_SA(0, 0), a2, voffA);
            PG8_WAIT_V(8); PG8_WAIT_L(0); PG8_BAR; PG8_MMA(1, 0, At, B0); PG8_MMA(1, 1, At, B1); PG8_BAR; PG8_SCHED;
            PG8_LDB(B0, 1, 0); PG8_LDB(B1, 1, 1); PG8_SCHED; PG8_LDA(At, 1, 0); PG8_STAGE(PG8_SA(0, 1), a2 + hstepA, voffA);
            PG8_WAIT_V(8); PG8_WAIT_L(0); PG8_BAR; PG8_MMA(0, 0, At, B0); PG8_MMA(0, 1, At, B1); PG8_BAR; PG8_SCHED;
            PG8_LDA(At, 1, 1); PG8_STAGE(PG8_SB(1, 0), b3, voffB); PG8_STAGE(PG8_SB(1, 1), b3 + hstepB, voffB); PG8_STAGE(PG8_SA(1, 0), a3, voffA);
            PG8_WAIT_V(8); PG8_WAIT_L(0); PG8_BAR; PG8_MMA(1, 0, At, B0); PG8_MMA(1, 1, At, B1); PG8_BAR; PG8_SCHED;
        }
        if (wr == 0) PG8_BAR;
        E(acc, cur, wr, wc, fr, fq);
        if (!has_next) break;
        if (!(Epi::TWO_PART && cur.part == 0)) {
#pragma unroll
        for (int a = 0; a < 2; ++a)
#pragma unroll
            for (int b = 0; b < 2; ++b)
#pragma unroll
                for (int m = 0; m < 4; ++m)
#pragma unroll
                    for (int n = 0; n < 2; ++n) acc[a][b][m][n] = (f32x4){0.f, 0.f, 0.f, 0.f};
        }
        cur = nxt; cA = nA; cB = nB; ++ui;
        if (wr == 1) PG8_BAR;
    }
    PG8_WAIT_V(0);
    PG8_BAR;
#undef PG8_SA
#undef PG8_SB
#undef PG8_STAGE
#undef PG8_LDA
#undef PG8_LDB
#undef PG8_MMA
#undef PG8_WAIT_V
#undef PG8_WAIT_L
#undef PG8_BAR
#undef PG8_SCHED
}

typedef f32x4 Acc[2][2][4][2];

struct EpiG1 {
    static constexpr bool TWO_PART = false;
    _Float16* UF; bf16_t* UP; bf16_t* GT;
    __device__ __forceinline__ void operator()(const Acc& acc, const Unit& u, int wr, int wc, int fr, int fq) const {
        const int row0 = u.pm * BM + wr * 64 + fr, c0 = wc * 32 + 8 * fq, pn = u.pn;
#pragma unroll
        for (int ai = 0; ai < 2; ++ai)
#pragma unroll
            for (int m = 0; m < 4; ++m) { const size_t row = (size_t)(row0 + ai * HALF + m * 16);
#pragma unroll
                for (int bj = 0; bj < 2; ++bj) { const f32x4 v0 = acc[ai][bj][m][0], v1 = acc[ai][bj][m][1]; const int c = c0 + bj * HALF; u32x4 w;
                    if (pn < 2) { w.x = pk_f16(v0[0], v0[1]); w.y = pk_f16(v0[2], v0[3]); w.z = pk_f16(v1[0], v1[1]); w.w = pk_f16(v1[2], v1[3]);
                        *(u32x4*)(UF + row * 512 + pn * 256 + c) = w; }
                    else if (pn < 4) { w.x = cvt_pk_bf16(v0[0], v0[1]); w.y = cvt_pk_bf16(v0[2], v0[3]); w.z = cvt_pk_bf16(v1[0], v1[1]); w.w = cvt_pk_bf16(v1[2], v1[3]);
                        *(u32x4*)(UP + row * 512 + (pn - 2) * 256 + c) = w; }
                    else if (bj == 0) {
                        const f32x4 q0 = acc[ai][1][m][0], q1 = acc[ai][1][m][1]; float rt[8], sp[8];
#pragma unroll
                        for (int e = 0; e < 4; ++e) { const float ef0 = __expf(-v0[e]), ep0 = fminf(__expf(-q0[e]), 1e30f), ef1 = __expf(-v1[e]), ep1 = fminf(__expf(-q1[e]), 1e30f);
                            sp[e] = __builtin_amdgcn_rcpf(1.f + ep0); rt[e] = (1.f + ep0) * __builtin_amdgcn_rcpf(1.f + ef0); sp[4 + e] = __builtin_amdgcn_rcpf(1.f + ep1); rt[4 + e] = (1.f + ep1) * __builtin_amdgcn_rcpf(1.f + ef1); }
                        const int ch = (pn - 4) * 128 + c0;
                        w.x = cvt_pk_bf16(rt[0], rt[1]); w.y = cvt_pk_bf16(rt[2], rt[3]); w.z = cvt_pk_bf16(rt[4], rt[5]); w.w = cvt_pk_bf16(rt[6], rt[7]);
                        __builtin_nontemporal_store(w, (u32x4*)(GT + row * 2048 + ch));
                        w.x = cvt_pk_bf16(sp[0], sp[1]); w.y = cvt_pk_bf16(sp[2], sp[3]); w.z = cvt_pk_bf16(sp[4], sp[5]); w.w = cvt_pk_bf16(sp[6], sp[7]);
                        __builtin_nontemporal_store(w, (u32x4*)(GT + row * 2048 + 1024 + ch)); } } }
    }
};
struct EpiMix2 {
    static constexpr bool TWO_PART = true;
    bf16_t* MIX; const bf16_t* GT;
    __device__ __forceinline__ void operator()(Acc& acc, const Unit& u, int wr, int wc, int fr, int fq) const {
        const int row0 = u.pm * BM + wr * 64 + fr, c0 = u.pn * BM + wc * 32 + 8 * fq;
#pragma unroll
        for (int ai = 0; ai < 2; ++ai)
#pragma unroll
            for (int m = 0; m < 4; ++m) { const size_t row = (size_t)(row0 + ai * HALF + m * 16);
#pragma unroll
                for (int bj = 0; bj < 2; ++bj) { const int c = c0 + bj * HALF;
                    const u32x4 gq = __builtin_nontemporal_load((const u32x4*)(GT + row * 2048 + (u.part == 0 ? 0 : 1024) + c));
                    const float p[8] = {bf_lo(gq.x), bf_hi(gq.x), bf_lo(gq.y), bf_hi(gq.y), bf_lo(gq.z), bf_hi(gq.z), bf_lo(gq.w), bf_hi(gq.w)};
                    if (u.part == 0) {
#pragma unroll
                        for (int e = 0; e < 4; ++e) { acc[ai][bj][m][0][e] *= p[e]; acc[ai][bj][m][1][e] *= p[4 + e]; }
                    } else {
                        const f32x4 v0 = acc[ai][bj][m][0], v1 = acc[ai][bj][m][1];
                        u32x4 w; w.x = cvt_pk_bf16(v0[0] * p[0], v0[1] * p[1]); w.y = cvt_pk_bf16(v0[2] * p[2], v0[3] * p[3]); w.z = cvt_pk_bf16(v1[0] * p[4], v1[1] * p[5]); w.w = cvt_pk_bf16(v1[2] * p[6], v1[3] * p[7]);
                        *(u32x4*)(MIX + row * 1024 + c) = w; } } }
    }
};
struct EpiRowSS {
    static constexpr bool TWO_PART = false;
    bf16_t* O; float* ss;
    __device__ __forceinline__ void operator()(const Acc& acc, const Unit& u, int wr, int wc, int fr, int fq) const {
        const int row0 = u.pm * BM + wr * 64 + fr, c0 = u.pn * BM + wc * 32 + 8 * fq;
#pragma unroll
        for (int ai = 0; ai < 2; ++ai)
#pragma unroll
            for (int m = 0; m < 4; ++m) { const size_t row = (size_t)(row0 + ai * HALF + m * 16); float p = 0.f;
#pragma unroll
                for (int bj = 0; bj < 2; ++bj) { const f32x4 v0 = acc[ai][bj][m][0], v1 = acc[ai][bj][m][1]; const int c = c0 + bj * HALF;
                    p += (v0[0] * v0[0] + v0[1] * v0[1]) + (v0[2] * v0[2] + v0[3] * v0[3]) + (v1[0] * v1[0] + v1[1] * v1[1]) + (v1[2] * v1[2] + v1[3] * v1[3]);
                    u32x4 w; w.x = cvt_pk_bf16(v0[0], v0[1]); w.y = cvt_pk_bf16(v0[2], v0[3]); w.z = cvt_pk_bf16(v1[0], v1[1]); w.w = cvt_pk_bf16(v1[2], v1[3]);
                    *(u32x4*)(O + row * 1024 + c) = w; }
                p += __shfl_xor(p, 16); p += __shfl_xor(p, 32);
                if (fq == 0) ss[row * 16 + u.pn * 4 + wc] = p; }
    }
};
struct EpiFinal {
    static constexpr bool TWO_PART = false;
    float* out; const bf16_t* x1b; const float* ada; const float* gpost; float* ssx; unsigned* ctr; LAS float* xl;
    __device__ __forceinline__ void operator()(const Acc& acc, const Unit& u, int wr, int wc, int fr, int fq) const {
        const int tid = threadIdx.x, lrow0 = wr * 64 + fr;
#pragma unroll
        for (int ai = 0; ai < 2; ++ai)
#pragma unroll
            for (int m = 0; m < 4; ++m) { float p = 0.f;
#pragma unroll
                for (int bj = 0; bj < 2; ++bj) { const f32x4 v0 = acc[ai][bj][m][0], v1 = acc[ai][bj][m][1];
                    p += (v0[0] * v0[0] + v0[1] * v0[1]) + (v0[2] * v0[2] + v0[3] * v0[3]) + (v1[0] * v1[0] + v1[1] * v1[1]) + (v1[2] * v1[2] + v1[3] * v1[3]); }
                p += __shfl_xor(p, 16); p += __shfl_xor(p, 32);
                if (fq == 0) xl[wc * 256 + ai * HALF + m * 16 + lrow0] = p; }
        __syncthreads();
        float* slot = ssx + ((size_t)u.pm * 4) * 256;
        if (tid < 256) { const float sv = (xl[tid] + xl[256 + tid]) + (xl[512 + tid] + xl[768 + tid]);
            __hip_atomic_store((unsigned*)(slot + u.pn * 256 + tid), __builtin_bit_cast(unsigned, sv), __ATOMIC_RELAXED, __HIP_MEMORY_SCOPE_AGENT); }
        asm volatile("s_waitcnt vmcnt(0)" ::: "memory");
        __syncthreads();
        if (tid == 0) { unsigned* c = ctr + u.pm * 16;
            __hip_atomic_fetch_add(c, 1u, __ATOMIC_RELAXED, __HIP_MEMORY_SCOPE_AGENT);
            unsigned sp = 0; while (__hip_atomic_load(c, __ATOMIC_RELAXED, __HIP_MEMORY_SCOPE_AGENT) < 4u) { __builtin_amdgcn_s_sleep(1); if (++sp > (1u << 22)) break; } }
        __syncthreads();
        if (tid < 256) { float sv = 0.f;
#pragma unroll
            for (int pn = 0; pn < 4; ++pn) sv += __builtin_bit_cast(float, __hip_atomic_load((unsigned*)(slot + pn * 256 + tid), __ATOMIC_RELAXED, __HIP_MEMORY_SCOPE_AGENT));
            xl[1024 + tid] = rsqrtf(sv * (1.f / D) + EPS); }
        __syncthreads();
        int r, tb, S; tok_info(u.pm * BM, r, tb, S);
        const int c0 = u.pn * BM + wc * 32 + 8 * fq;
        float gg[2][8];
#pragma unroll
        for (int bj = 0; bj < 2; ++bj) { const float* gt = ada + (size_t)r * NADA + 5 * D + c0 + bj * HALF; const float* gp = gpost + c0 + bj * HALF;
            const f32x4 a0 = *(const f32x4*)gt, a1 = *(const f32x4*)(gt + 4), b0 = *(const f32x4*)gp, b1 = *(const f32x4*)(gp + 4);
#pragma unroll
            for (int e = 0; e < 4; ++e) { gg[bj][e] = a0[e] * b0[e]; gg[bj][4 + e] = a1[e] * b1[e]; } }
#pragma unroll
        for (int ai = 0; ai < 2; ++ai)
#pragma unroll
            for (int m = 0; m < 4; ++m) { const int lr = ai * HALF + m * 16 + lrow0; const float rs = xl[1024 + lr]; float* orow = out + (size_t)(u.pm * BM + lr) * D + c0;
#pragma unroll
                for (int bj = 0; bj < 2; ++bj) { const u32x4 xb = __builtin_nontemporal_load((const u32x4*)(x1b + (size_t)(u.pm * BM + lr) * D + c0 + bj * HALF));
                    f32x4 x0 = {bf_lo(xb.x), bf_hi(xb.x), bf_lo(xb.y), bf_hi(xb.y)}, x1 = {bf_lo(xb.z), bf_hi(xb.z), bf_lo(xb.w), bf_hi(xb.w)}; const f32x4 v0 = acc[ai][bj][m][0], v1 = acc[ai][bj][m][1];
#pragma unroll
                    for (int e = 0; e < 4; ++e) { x0[e] += gg[bj][e] * (v0[e] * rs); x1[e] += gg[bj][4 + e] * (v1[e] * rs); }
                    __builtin_nontemporal_store(x0, (f32x4*)(orow + bj * HALF)); __builtin_nontemporal_store(x1, (f32x4*)(orow + bj * HALF + 4)); } }
    }
};
struct EpiSwiGLU {
    static constexpr bool TWO_PART = false;
    bf16_t* SB;
    __device__ __forceinline__ void operator()(const Acc& acc, const Unit& u, int wr, int wc, int fr, int fq) const {
        const int row0 = u.pm * BM + wr * 64 + fr, c0 = u.pn * HALF + wc * 32 + 8 * fq;
#pragma unroll
        for (int ai = 0; ai < 2; ++ai)
#pragma unroll
            for (int m = 0; m < 4; ++m) { const size_t row = (size_t)(row0 + ai * HALF + m * 16);
                const f32x4 a0 = acc[ai][0][m][0], a1 = acc[ai][0][m][1], b0 = acc[ai][1][m][0], b1 = acc[ai][1][m][1];
                float o[8];
#pragma unroll
                for (int i = 0; i < 4; ++i) { o[i] = a0[i] * sigmoid_f(a0[i]) * b0[i]; o[4 + i] = a1[i] * sigmoid_f(a1[i]) * b1[i]; }
                u32x4 w; w.x = cvt_pk_bf16(o[0], o[1]); w.y = cvt_pk_bf16(o[2], o[3]); w.z = cvt_pk_bf16(o[4], o[5]); w.w = cvt_pk_bf16(o[6], o[7]);
                __builtin_nontemporal_store(w, (u32x4*)(SB + row * FF + c0)); }
    }
};
}

struct Args { const float* in[19]; float* out; unsigned char* ws; };

template <class Src4>
__device__ __forceinline__ void wave_transpose(Src4 src4, bf16_t* out, int ldo, int k0, int n0, int ocol0, int orow0, LAS float* scr, int lane) {
    f32x4 v[8];
#pragma unroll
    for (int i = 0; i < 8; ++i) v[i] = src4(k0 + 8 * i + (lane >> 3), n0 + 4 * (lane & 7));
#pragma unroll
    for (int i = 0; i < 8; ++i) { LAS float* d = scr + (8 * i + (lane >> 3)) * 33 + 4 * (lane & 7); d[0] = v[i].x; d[1] = v[i].y; d[2] = v[i].z; d[3] = v[i].w; }
    asm volatile("s_waitcnt lgkmcnt(0)" ::: "memory");
    const int c = lane & 7;
#pragma unroll
    for (int j = 0; j < 4; ++j) { const int n = (lane >> 3) + 8 * j; const LAS float* sp = scr + (8 * c) * 33 + n;
        u32x4 o; o.x = cvt_pk_bf16(sp[0 * 33], sp[1 * 33]); o.y = cvt_pk_bf16(sp[2 * 33], sp[3 * 33]); o.z = cvt_pk_bf16(sp[4 * 33], sp[5 * 33]); o.w = cvt_pk_bf16(sp[6 * 33], sp[7 * 33]);
        *(u32x4*)(out + (size_t)(orow0 + n) * ldo + ocol0 + 8 * c) = o; }
    asm volatile("s_waitcnt lgkmcnt(0)" ::: "memory");
}

__device__ __forceinline__ void weight_item(const Args& a, int it, LAS float* scr, int lane) {
    unsigned char* ws = a.ws;
    constexpr int I_W1 = 16 * 96, I_W2A = 8 * 32, I_W3 = 16 * 32, I_W4 = 16 * 176;
    int r = it;
    if (r < I_W1) { const float* W = a.in[7]; const int kb = r / 96, nb = r % 96, n0 = nb * 32;
        const int src0 = n0 < 1024 ? n0 : 1024 + (((n0 - 1024) >> 7) & 1) * 1024 + ((n0 - 1024) >> 8) * 128 + (n0 & 127);
        wave_transpose([=](int k, int n) { return __builtin_nontemporal_load((const f32x4*)(W + (size_t)k * 3072 + n)); }, (bf16_t*)(ws + WS_W1T), 1024, kb * 64, src0, kb * 64, n0, scr, lane); return; }
    r -= I_W1;
    if (r < I_W2A) { const float* W = a.in[8]; const int kb = r >> 5, nb = r & 31;
        wave_transpose([=](int k, int n) { return __builtin_nontemporal_load((const f32x4*)(W + (size_t)k * 1024 + n)); }, (bf16_t*)(ws + WS_W2T), 1024, kb * 64, nb * 32, kb * 64, nb * 32, scr, lane); return; }
    r -= I_W2A;
    if (r < I_W3) { const float* W = a.in[12]; const int kb = r >> 5, nb = r & 31;
        wave_transpose([=](int k, int n) { return __builtin_nontemporal_load((const f32x4*)(W + (size_t)k * 1024 + n)); }, (bf16_t*)(ws + WS_W3T), 1024, kb * 64, nb * 32, kb * 64, nb * 32, scr, lane); return; }
    r -= I_W3;
    if (r < I_W4) { const int kb = r / 176, nb = r % 176; const int n0 = nb * 32;
        const int j = n0 >> 8, bj = (n0 >> 7) & 1, cbase = j * 128 + (n0 & 127); const float* W = bj ? a.in[16] : a.in[15];
        wave_transpose([=](int k, int n) { return __builtin_nontemporal_load((const f32x4*)(W + (size_t)k * FF + n)); }, (bf16_t*)(ws + WS_W4T), 1024, kb * 64, cbase, kb * 64, n0, scr, lane); return; }
    r -= I_W4;
    { const float* W = a.in[17]; const int kb = r >> 5, nb = r & 31;
        wave_transpose([=](int k, int n) { return __builtin_nontemporal_load((const f32x4*)(W + (size_t)k * 1024 + n)); }, (bf16_t*)(ws + WS_W5T), FF, kb * 64, nb * 32, kb * 64, nb * 32, scr, lane); }
}
constexpr int N_WEIGHT_ITEMS = 16 * 96 + 8 * 32 + 16 * 32 + 16 * 176 + 44 * 32;

__device__ __forceinline__ void phase_prep(const Args& a, LAS unsigned char* lds, int G) {
    unsigned char* ws = a.ws;
    const int tid = threadIdx.x, lane = tid & 63, wave = tid >> 6;
    {
        const int gt = blockIdx.x * NTHR + tid, NG = G * NTHR;
        float2* ROOT = (float2*)(ws + WS_ROOT);
        for (int j = gt; j < 16384; j += NG) { float s, c; sincospif((float)j * (1.f / 8192.f), &s, &c); ROOT[j] = make_float2(c, s); }
        _Float16* FC = (_Float16*)(ws + WS_FC); _Float16* FS = FC + 128 * FT_LD;
        for (int j = gt; j < 128 * FT_LD; j += NG) { const int n = j / FT_LD, k = j % FT_LD; float s = 0.f, c = 0.f;
            if (k < 128) { sincospif((float)((n * k) & 127) * (1.f / 64.f), &s, &c); s *= 0.08838834764831845f; c *= 0.08838834764831845f; }
            FC[j] = (_Float16)c; FS[j] = (_Float16)s; }
    }
    LAS float* scr = (LAS float*)lds;
    constexpr int I_ADA = 192;
    for (int it = blockIdx.x; it < I_ADA; it += G) {
        const int e0 = it * 32; const float* cp = a.in[2]; const float* cs = a.in[3]; const float* wada = a.in[4]; const float* bada = a.in[5];
        LAS float* sc = scr;
        LAS float* red = scr + NB * 1024;
        for (int j = tid; j < NB * 1024; j += NTHR) { const float v = (j < 2048) ? cp[j] : cs[j - 2048]; sc[j] = v / (1.f + expf(-v)); }
        __syncthreads();
        const int col = tid & 31, dg = tid >> 5; float accv[NB];
#pragma unroll
        for (int q = 0; q < NB; ++q) accv[q] = 0.f;
        for (int d0 = dg * 64; d0 < dg * 64 + 64; d0 += 16) { float wv[16];
#pragma unroll
            for (int u = 0; u < 16; ++u) wv[u] = __builtin_nontemporal_load(wada + (size_t)(d0 + u) * NADA + e0 + col);
#pragma unroll
            for (int u = 0; u < 16; ++u)
#pragma unroll
                for (int q = 0; q < NB; ++q) accv[q] += sc[q * 1024 + d0 + u] * wv[u]; }
#pragma unroll
        for (int q = 0; q < NB; ++q) red[(dg * NB + q) * 32 + col] = accv[q];
        __syncthreads();
        if (tid < NB * 32) { const int q = tid >> 5, cc = tid & 31; float s = bada[e0 + cc];
            for (int k = 0; k < 16; ++k) s += red[(k * NB + q) * 32 + cc];
            ((float*)(ws + WS_ADA))[q * NADA + e0 + cc] = s; }
        __syncthreads();
    }
    __syncthreads();
    LAS float* wscr = scr + wave * (64 * 33);
    const int gw = (int)blockIdx.x * NWAVES + wave, NW = G * NWAVES;
    for (int r = gw; r < 2048; r += NW) {
        const int k0 = (r >> 5) * 8, n0 = (r & 31) * 32, k = k0 + (lane >> 3), n = n0 + 4 * (lane & 7), gb = k & ~127;
        const float* pg = a.in[9] + (size_t)k * 128; const float* ps = a.in[10] + gb; const float* wpo = a.in[11] + (size_t)gb * 1024 + n;
        f32x4 s4 = {0.f, 0.f, 0.f, 0.f};
#pragma unroll 8
        for (int d = 0; d < 128; ++d) { const float c = pg[d] * ps[d]; const f32x4 wv = *(const f32x4*)(wpo + (size_t)d * 1024); s4 += wv * c; }
        LAS float* dd = wscr + (lane >> 3) * 33 + 4 * (lane & 7); dd[0] = s4.x; dd[1] = s4.y; dd[2] = s4.z; dd[3] = s4.w;
        asm volatile("s_waitcnt lgkmcnt(0)" ::: "memory");
        if (lane < 32) { const LAS float* sp = wscr + lane;
            u32x4 o; o.x = cvt_pk_bf16(sp[0 * 33], sp[1 * 33]); o.y = cvt_pk_bf16(sp[2 * 33], sp[3 * 33]); o.z = cvt_pk_bf16(sp[4 * 33], sp[5 * 33]); o.w = cvt_pk_bf16(sp[6 * 33], sp[7 * 33]);
            *(u32x4*)((bf16_t*)(ws + WS_W2T) + (size_t)(n0 + lane) * 1024 + 512 + k0) = o; }
        asm volatile("s_waitcnt lgkmcnt(0)" ::: "memory");
    }
    if (G == 256) {
        constexpr int NEXTRA = 2048;
        if (blockIdx.x >= I_ADA) for (int it = ((int)blockIdx.x - I_ADA) * NWAVES + wave; it < NEXTRA; it += 64 * NWAVES) weight_item(a, it, wscr, lane);
        for (int it = NEXTRA + gw; it < N_WEIGHT_ITEMS; it += NW) weight_item(a, it, wscr, lane);
    } else {
        for (int it = gw; it < N_WEIGHT_ITEMS; it += NW) weight_item(a, it, wscr, lane);
    }
}

__device__ __forceinline__ const float* xrow_ptr(const Args& a, int t) { return t < TP ? a.in[0] + (size_t)t * D : a.in[1] + (size_t)(t - TP) * D; }

template <int R>
__device__ __forceinline__ void phase_norm1(const Args& a, int G) {
    const int lane = threadIdx.x & 63, wave = __builtin_amdgcn_readfirstlane(threadIdx.x >> 6), gw = blockIdx.x * NWAVES + wave, NW = G * NWAVES;
    const float* ada = (const float*)(a.ws + WS_ADA); bf16_t* H = (bf16_t*)(a.ws + WS_H); const float* gpre = a.in[6];
    f32x4 gp[4];
#pragma unroll
    for (int j = 0; j < 4; ++j) gp[j] = ((const f32x4*)gpre + lane)[64 * j];
    for (int t0 = gw; t0 < T; t0 += R * NW) {
        f32x4 v[R][4], sc[R][4], sh[R][4]; int rprev = -1;
#pragma unroll
        for (int k = 0; k < R; ++k) { const int t = t0 + k * NW; if (t < T) { int r, tb, S; tok_info(t, r, tb, S);
            const f32x4* xr = (const f32x4*)xrow_ptr(a, t) + lane;
#pragma unroll
            for (int j = 0; j < 4; ++j) v[k][j] = __builtin_nontemporal_load(xr + 64 * j);
            if (k > 0 && r == rprev) {
#pragma unroll
                for (int j = 0; j < 4; ++j) { sc[k][j] = sc[k > 0 ? k - 1 : 0][j]; sh[k][j] = sh[k > 0 ? k - 1 : 0][j]; }
            } else { const f32x4* shp = (const f32x4*)(ada + (size_t)r * NADA) + lane; const f32x4* scp = (const f32x4*)(ada + (size_t)r * NADA + D) + lane;
#pragma unroll
                for (int j = 0; j < 4; ++j) { sc[k][j] = scp[64 * j]; sh[k][j] = shp[64 * j]; } }
            rprev = r; } }
#pragma unroll
        for (int k = 0; k < R; ++k) { const int t = t0 + k * NW; if (t < T) { float s = 0.f;
#pragma unroll
            for (int j = 0; j < 4; ++j) s += (v[k][j].x * v[k][j].x + v[k][j].y * v[k][j].y) + (v[k][j].z * v[k][j].z + v[k][j].w * v[k][j].w);
            const float rs = rsqrtf(wave_sum(s) * (1.f / D) + EPS);
            u32x2* o = (u32x2*)(H + (size_t)t * D) + lane;
#pragma unroll
            for (int j = 0; j < 4; ++j) { const f32x4 g = gp[j], c = sc[k][j], h = sh[k][j], x = v[k][j]; f32x4 y;
                y.x = x.x * rs * g.x * (1.f + c.x) + h.x; y.y = x.y * rs * g.y * (1.f + c.y) + h.y; y.z = x.z * rs * g.z * (1.f + c.z) + h.z; y.w = x.w * rs * g.w * (1.f + c.w) + h.w;
                u32x2 w; w.x = cvt_pk_bf16(y.x, y.y); w.y = cvt_pk_bf16(y.z, y.w); o[64 * j] = w; } } }
    }
}
template <int R>
__device__ __forceinline__ void phase_mid(const Args& a, int G) {
    const int lane = threadIdx.x & 63, wave = __builtin_amdgcn_readfirstlane(threadIdx.x >> 6), gw = blockIdx.x * NWAVES + wave, NW = G * NWAVES;
    const float* ada = (const float*)(a.ws + WS_ADA); bf16_t* H = (bf16_t*)(a.ws + WS_H); const bf16_t* MB = (const bf16_t*)(a.ws + WS_MBUF);
    const float* ss1 = (const float*)(a.ws + WS_SS1); const float* gpost = a.in[13]; const float* gpre = a.in[14];
    f32x4 gq[4], gp2[4];
#pragma unroll
    for (int j = 0; j < 4; ++j) { gq[j] = ((const f32x4*)gpost + lane)[64 * j]; gp2[j] = ((const f32x4*)gpre + lane)[64 * j]; }
    for (int t0 = gw; t0 < T; t0 += R * NW) {
        f32x4 v[R][4], g1[R][4]; u32x2 mw[R][4]; float sp[R];
#pragma unroll
        for (int k = 0; k < R; ++k) { const int t = t0 + k * NW; if (t < T) { int r, tb, S; tok_info(t, r, tb, S);
            const f32x4* xr = (const f32x4*)xrow_ptr(a, t) + lane; const u32x2* mr = (const u32x2*)(MB + (size_t)t * D) + lane; const f32x4* gt = (const f32x4*)(ada + (size_t)r * NADA + 2 * D) + lane;
            sp[k] = ss1[(size_t)t * 16 + (lane & 15)];
#pragma unroll
            for (int j = 0; j < 4; ++j) { v[k][j] = __builtin_nontemporal_load(xr + 64 * j); mw[k][j] = __builtin_nontemporal_load(mr + 64 * j); g1[k][j] = gt[64 * j]; } } }
        f32x4 sh[4], sc[4]; int rprev2 = -1;
#pragma unroll
        for (int k = 0; k < R; ++k) { const int t = t0 + k * NW; if (t < T) { int r, tb, S; tok_info(t, r, tb, S);
            if (!(k > 0 && r == rprev2)) { const f32x4* shp = (const f32x4*)(ada + (size_t)r * NADA + 3 * D) + lane; const f32x4* scp = (const f32x4*)(ada + (size_t)r * NADA + 4 * D) + lane;
#pragma unroll
                for (int j = 0; j < 4; ++j) { sh[j] = shp[64 * j]; sc[j] = scp[64 * j]; } }
            rprev2 = r;
            float q = sp[k]; q += __shfl_xor(q, 1); q += __shfl_xor(q, 2); q += __shfl_xor(q, 4); q += __shfl_xor(q, 8);
            const float rs1 = rsqrtf(q * (1.f / D) + EPS); float s = 0.f;
#pragma unroll
            for (int j = 0; j < 4; ++j) { f32x4 x = v[k][j]; const f32x4 gg = g1[k][j], gp = gq[j]; const u32x2 m = mw[k][j];
                x.x += gg.x * (bf_lo(m.x) * rs1 * gp.x); x.y += gg.y * (bf_hi(m.x) * rs1 * gp.y); x.z += gg.z * (bf_lo(m.y) * rs1 * gp.z); x.w += gg.w * (bf_hi(m.y) * rs1 * gp.w);
                v[k][j] = x; s += (x.x * x.x + x.y * x.y) + (x.z * x.z + x.w * x.w); }
            const float rs = rsqrtf(wave_sum(s) * (1.f / D) + EPS);
            f32x4* xo = (f32x4*)(a.out + (size_t)t * D) + lane; u32x2* o = (u32x2*)(H + (size_t)t * D) + lane;
#pragma unroll
            for (int j = 0; j < 4; ++j) { const f32x4 x = v[k][j];
                if (G == 256) { u32x2 xb; xb.x = cvt_pk_bf16(x.x, x.y); xb.y = cvt_pk_bf16(x.z, x.w); __builtin_nontemporal_store(xb, (u32x2*)((bf16_t*)(a.ws + WS_X1B) + (size_t)t * D) + lane + 64 * j); }
                else __builtin_nontemporal_store(x, xo + 64 * j);
                const f32x4 g = gp2[j], c = sc[j], h = sh[j]; f32x4 y;
                y.x = x.x * rs * g.x * (1.f + c.x) + h.x; y.y = x.y * rs * g.y * (1.f + c.y) + h.y; y.z = x.z * rs * g.z * (1.f + c.z) + h.z; y.w = x.w * rs * g.w * (1.f + c.w) + h.w;
                u32x2 w; w.x = cvt_pk_bf16(y.x, y.y); w.y = cvt_pk_bf16(y.z, y.w); o[64 * j] = w; } } }
    }
}
template <int R>
__device__ __forceinline__ void phase_final(const Args& a, int G) {
    const int lane = threadIdx.x & 63, wave = threadIdx.x >> 6, gw = blockIdx.x * NWAVES + wave, NW = G * NWAVES;
    const float* ada = (const float*)(a.ws + WS_ADA); const bf16_t* ZB = (const bf16_t*)(a.ws + WS_ZBUF);
    const float* ss2 = (const float*)(a.ws + WS_SS2); const float* gpost = a.in[18];
    f32x4 gq[4];
#pragma unroll
    for (int j = 0; j < 4; ++j) gq[j] = ((const f32x4*)gpost + lane)[64 * j];
    for (int t0 = gw; t0 < T; t0 += R * NW) {
        f32x4 v[R][4], g2[R][4]; u32x2 zw[R][4]; float sp[R];
#pragma unroll
        for (int k = 0; k < R; ++k) { const int t = t0 + k * NW; if (t < T) { int r, tb, S; tok_info(t, r, tb, S);
            const f32x4* xr = (const f32x4*)(a.out + (size_t)t * D) + lane; const u32x2* zr = (const u32x2*)(ZB + (size_t)t * D) + lane; const f32x4* gt = (const f32x4*)(ada + (size_t)r * NADA + 5 * D) + lane;
            sp[k] = ss2[(size_t)t * 16 + (lane & 15)];
#pragma unroll
            for (int j = 0; j < 4; ++j) { v[k][j] = xr[64 * j]; zw[k][j] = zr[64 * j]; g2[k][j] = gt[64 * j]; } } }
#pragma unroll
        for (int k = 0; k < R; ++k) { const int t = t0 + k * NW; if (t < T) {
            float q = sp[k]; q += __shfl_xor(q, 1); q += __shfl_xor(q, 2); q += __shfl_xor(q, 4); q += __shfl_xor(q, 8);
            const float rs2 = rsqrtf(q * (1.f / D) + EPS);
            f32x4* xo = (f32x4*)(a.out + (size_t)t * D) + lane;
#pragma unroll
            for (int j = 0; j < 4; ++j) { f32x4 x = v[k][j]; const f32x4 gg = g2[k][j], gp = gq[j]; const u32x2 z = zw[k][j];
                x.x += gg.x * (bf_lo(z.x) * rs2 * gp.x); x.y += gg.y * (bf_hi(z.x) * rs2 * gp.y); x.z += gg.z * (bf_lo(z.y) * rs2 * gp.z); x.w += gg.w * (bf_hi(z.y) * rs2 * gp.w);
                xo[64 * j] = x; } } }
    }
}
template <int W>
__device__ __forceinline__ void pool_task(const bf16_t* UP, bf16_t* A2, int t0, int g, int lane) {
    constexpr int L = W / 2, NR = 32 + W - 1;
    int r, tb, S; tok_info(t0, r, tb, S);
    const int s0 = t0 - tb;
    unsigned row[NR];
#pragma unroll
    for (int j = 0; j < NR; ++j) { const int p = s0 - L + j; row[j] = (p >= 0 && p < S) ? __builtin_nontemporal_load((const unsigned*)(UP + (size_t)(tb + p) * 512 + g * 128) + lane) : 0u; }
    float slo = 0.f, shi = 0.f;
#pragma unroll
    for (int j = 0; j < W - 1; ++j) { slo += bf_lo(row[j]); shi += bf_hi(row[j]); }
#pragma unroll
    for (int i = 0; i < 32; ++i) {
        slo += bf_lo(row[i + W - 1]); shi += bf_hi(row[i + W - 1]);
        const int s = s0 + i, lo = max(s - L, 0), hi = min(s + (W - 1 - L), S - 1); const float inv = __builtin_amdgcn_rcpf((float)(hi - lo + 1));
        *((unsigned*)(A2 + (size_t)(t0 + i) * 1024 + 512 + g * 128) + lane) = cvt_pk_bf16(slo * inv - bf_lo(row[i + L]), shi * inv - bf_hi(row[i + L]));
        slo -= bf_lo(row[i]); shi -= bf_hi(row[i]);
    }
}
__device__ __forceinline__ void phase_pool(const Args& a, int G) {
    const int lane = threadIdx.x & 63, wave = __builtin_amdgcn_readfirstlane(threadIdx.x >> 6), gw = blockIdx.x * NWAVES + wave, NW = G * NWAVES;
    const bf16_t* UP = (const bf16_t*)(a.ws + WS_UP); bf16_t* A2 = (bf16_t*)(a.ws + WS_A2);
    int k = 0;
    for (int task = gw; task < (T / 32) * 4; task += NW, ++k) {
        const int chunk = task >> 2, g = (task + k) & 3, t0 = chunk * 32;
        if (g == 0) pool_task<2>(UP, A2, t0, 0, lane); else if (g == 1) pool_task<4>(UP, A2, t0, 1, lane); else if (g == 2) pool_task<8>(UP, A2, t0, 2, lane); else pool_task<16>(UP, A2, t0, 3, lane);
    }
}

__device__ __forceinline__ void fft_load_tables(const Args& a, LAS unsigned char* lds) {
    const u32x4* src = (const u32x4*)(a.ws + WS_FC); LAS u32x4* dst = (LAS u32x4*)lds;
    for (int i = threadIdx.x; i < 2 * FT_BYTES / 16; i += NTHR) dst[i] = src[i];
    __syncthreads();
}
__device__ __forceinline__ half8 pack_acc(const f32x4 lo, const f32x4 hi) {
    half8 h; h[0] = (_Float16)lo[0]; h[1] = (_Float16)lo[1]; h[2] = (_Float16)lo[2]; h[3] = (_Float16)lo[3]; h[4] = (_Float16)hi[0]; h[5] = (_Float16)hi[1]; h[6] = (_Float16)hi[2]; h[7] = (_Float16)hi[3]; return h;
}
__device__ __forceinline__ half8 neg_h8(half8 v) { u32x4 u = __builtin_bit_cast(u32x4, v); u.x ^= 0x80008000u; u.y ^= 0x80008000u; u.z ^= 0x80008000u; u.w ^= 0x80008000u; return __builtin_bit_cast(half8, u); }
__device__ __forceinline__ half8 tab_frag(const LAS _Float16* tab, int row, int t, int q) {
    const LAS _Float16* p = tab + row * FT_LD + 32 * t + 4 * q; const half4 c0 = *(const LAS half4*)p, c1 = *(const LAS half4*)(p + 16);
    half8 h; h[0] = c0[0]; h[1] = c0[1]; h[2] = c0[2]; h[3] = c0[3]; h[4] = c1[0]; h[5] = c1[1]; h[6] = c1[2]; h[7] = c1[3]; return h;
}
#define MFMA_H(a, b, c) __builtin_amdgcn_mfma_f32_16x16x32_f16(a, b, c, 0, 0, 0)

struct ItemA { int g, s2, N2, tb, rmul; };
__device__ __forceinline__ ItemA decode_a(int it) {
    ItemA I;
    if (it < 1024) { const int b = it >> 9; I.g = (it >> 7) & 3; I.s2 = it & 127; I.N2 = 128; I.tb = b << 14; I.rmul = 1; }
    else { const int j = it - 1024, b = j >> 6; I.g = (j >> 4) & 3; I.s2 = j & 15; I.N2 = 16; I.tb = TP + (b << 11); I.rmul = 8; }
    return I;
}
__device__ __forceinline__ void fft_pass_a(const Args& a, LAS unsigned char* lds, int G) {
    const LAS _Float16* FC = (const LAS _Float16*)lds; const LAS _Float16* FS = FC + 128 * FT_LD;
    const int lane = threadIdx.x & 63, w = __builtin_amdgcn_readfirstlane(threadIdx.x >> 6), r = lane & 15, q = lane >> 4;
    const _Float16* UF = (const _Float16*)(a.ws + WS_UF); _Float16* T2 = (_Float16*)(a.ws + WS_H); const float2* ROOT = (const float2*)(a.ws + WS_ROOT);
    LAS _Float16* OT = (LAS _Float16*)(lds + 2 * FT_BYTES); constexpr int OTA_LD = 264;
    LAS f32x2_t* TW = (LAS f32x2_t*)(lds + 2 * FT_BYTES + 128 * OTA_LD * 2);
    f32x2_t twn = {1.f, 0.f};
    half8 U[8][4];
#define PA_LOAD(itx, R0) do { const ItemA J = decode_a(itx); const _Float16* ub = UF + (size_t)(J.tb + J.s2) * 512 + J.g * 128 + q * 8; \
        _Pragma("unroll") for (int rt = R0; rt < R0 + 4; ++rt) { const _Float16* p = ub + (size_t)(16 * rt + r) * J.N2 * 512; \
            _Pragma("unroll") for (int t = 0; t < 4; ++t) U[rt][t] = *(const half8*)(p + 32 * t); } } while (0)
    int it = blockIdx.x;
    if (it < 1536) { PA_LOAD(it, 0); if (threadIdx.x < 128) { const ItemA J = decode_a(it); { const float2 c_ = ROOT[(J.s2 * (int)threadIdx.x * J.rmul) & 16383]; twn = (f32x2_t){c_.x, c_.y}; } } }
    for (; it < 1536; it += G) {
        const ItemA I = decode_a(it); const int g = I.g, s2 = I.s2, N2 = I.N2, tb = I.tb, rmul = I.rmul;
        PA_LOAD(it, 4);
        if (threadIdx.x < 128) TW[threadIdx.x] = twn;
        half8 ZrB[4], ZiB[4];
        {
            half8 FcB[4], FsB[4];
#pragma unroll
            for (int t = 0; t < 4; ++t) { FcB[t] = *(const LAS half8*)(FC + (16 * w + r) * FT_LD + 32 * t + 8 * q); FsB[t] = *(const LAS half8*)(FS + (16 * w + r) * FT_LD + 32 * t + 8 * q); }
            f32x4 accR[8], accI[8];
#pragma unroll
            for (int rt = 0; rt < 8; ++rt) { f32x4 cr = {0.f, 0.f, 0.f, 0.f}, ci = {0.f, 0.f, 0.f, 0.f};
#pragma unroll
                for (int t = 0; t < 4; ++t) { cr = MFMA_H(U[rt][t], FcB[t], cr); ci = MFMA_H(U[rt][t], FsB[t], ci); }
                accR[rt] = cr; accI[rt] = ci; }
#pragma unroll
            for (int t = 0; t < 4; ++t) { ZrB[t] = pack_acc(accR[2 * t], accR[2 * t + 1]); ZiB[t] = pack_acc(accI[2 * t], accI[2 * t + 1]); }
        }
        if (it + G < 1536) { PA_LOAD(it + G, 0); if (threadIdx.x < 128) { const ItemA J = decode_a(it + G); { const float2 c_ = ROOT[(J.s2 * (int)threadIdx.x * J.rmul) & 16383]; twn = (f32x2_t){c_.x, c_.y}; } } }
        __syncthreads();
#pragma unroll 1
        for (int kt = 0; kt < 5; ++kt) {
            f32x4 P = {0.f, 0.f, 0.f, 0.f}, Q = P, R = P, S = P;
#pragma unroll
            for (int t = 0; t < 4; ++t) { const half8 fc = tab_frag(FC, 16 * kt + r, t, q), fs = tab_frag(FS, 16 * kt + r, t, q);
                P = MFMA_H(fc, ZrB[t], P); Q = MFMA_H(fs, ZiB[t], Q); R = MFMA_H(fc, ZiB[t], R); S = MFMA_H(fs, ZrB[t], S); }
#pragma unroll
            for (int j = 0; j < 4; ++j) { const int k1 = 16 * kt + 4 * q + j;
                if (kt < 4 || k1 == 64) { const f32x2_t cs = TW[k1]; const float Tr = P[j] - Q[j], Tn = R[j] + S[j];
                    LAS _Float16* o = OT + k1 * OTA_LD + 16 * w + r; o[0] = (_Float16)(Tr * cs.x - Tn * cs.y); o[128] = (_Float16)(-(Tn * cs.x + Tr * cs.y)); }
                if (kt < 4 && k1 != 0) { const int mk = 128 - k1; const f32x2_t cs = TW[mk]; const float Tr = P[j] + Q[j], Tn = R[j] - S[j];
                    LAS _Float16* o = OT + mk * OTA_LD + 16 * w + r; o[0] = (_Float16)(Tr * cs.x - Tn * cs.y); o[128] = (_Float16)(-(Tn * cs.x + Tr * cs.y)); } }
        }
        __syncthreads();
        {
            _Float16* dst = T2 + (size_t)tb * 1024 + (size_t)(g * 128) * N2 * 256 + (size_t)s2 * 256;
#pragma unroll
            for (int i = 0; i < 8; ++i) { const int c = threadIdx.x + i * NTHR, k1 = c >> 5, within = c & 31;
                const u32x4 vv = *(const LAS u32x4*)((const LAS unsigned char*)OT + k1 * (OTA_LD * 2) + within * 16);
                *(u32x4*)(dst + (size_t)k1 * N2 * 256 + within * 8) = vv; }
        }
    }
#undef PA_LOAD
}
__device__ __forceinline__ void fft_pass_b(const Args& a, LAS unsigned char* lds, int G) {
    const LAS _Float16* FC = (const LAS _Float16*)lds; const LAS _Float16* FS = FC + 128 * FT_LD;
    LAS bf16_t* OT = (LAS bf16_t*)(lds + 2 * FT_BYTES); constexpr int OTB_LD = 136;
    const int lane = threadIdx.x & 63, w = __builtin_amdgcn_readfirstlane(threadIdx.x >> 6), r = lane & 15, q = lane >> 4;
    const _Float16* T2 = (const _Float16*)(a.ws + WS_H); bf16_t* A2 = (bf16_t*)(a.ws + WS_A2); const float2* ROOT = (const float2*)(a.ws + WS_ROOT);
    half8 Sel, A16;
#pragma unroll
    for (int jj = 0; jj < 8; ++jj) { Sel[jj] = (8 * q + jj == 16 * (w & 1) + r) ? (_Float16)1.f : (_Float16)0.f;
        const int s2 = 4 * q + (jj & 3); const float2 cs = ROOT[((r * s2) & 15) * 1024]; A16[jj] = (_Float16)(0.25f * (jj < 4 ? cs.x : cs.y)); }
    const f32x4 zero = {0.f, 0.f, 0.f, 0.f};
    {
        half8 Lr[8], Li[8];
#define PB_LOAD(itx) do { const int b_ = (itx) >> 9, g_ = ((itx) >> 7) & 3, k1_ = (itx) & 127; \
        const _Float16* base_ = T2 + (size_t)(b_ << 14) * 1024 + (size_t)(g_ * 128 + k1_) * 128 * 256 + 32 * (w >> 1) + 8 * q; \
        _Pragma("unroll") for (int rt = 0; rt < 8; ++rt) { const _Float16* p = base_ + (16 * rt + r) * 256; Lr[rt] = *(const half8*)p; Li[rt] = *(const half8*)(p + 128); } } while (0)
        int it = blockIdx.x;
        if (it < 1024) PB_LOAD(it);
        for (; it < 1024; it += G) {
            const int b = it >> 9, g = (it >> 7) & 3, k1 = it & 127, tb = b << 14;
            half8 RB[4], IB[4];
            {
                f32x4 Dr[8], Di[8];
#pragma unroll
                for (int rt = 0; rt < 8; ++rt) { Dr[rt] = MFMA_H(Lr[rt], Sel, zero); Di[rt] = MFMA_H(Li[rt], Sel, zero); }
#pragma unroll
                for (int t = 0; t < 4; ++t) { RB[t] = pack_acc(Dr[2 * t], Dr[2 * t + 1]); IB[t] = pack_acc(Di[2 * t], Di[2 * t + 1]); }
            }
            if (it + G < 1024) PB_LOAD(it + G);
            __syncthreads();
#pragma unroll 1
            for (int kt = 0; kt < 5; ++kt) {
                f32x4 C = zero, Dd = zero;
#pragma unroll
                for (int t = 0; t < 4; ++t) { const half8 fc = tab_frag(FC, 16 * kt + r, t, q), fs = tab_frag(FS, 16 * kt + r, t, q);
                    C = MFMA_H(fc, RB[t], C); Dd = MFMA_H(fs, IB[t], Dd); }
#pragma unroll
                for (int j = 0; j < 4; ++j) { const int k2 = 16 * kt + 4 * q + j;
                    if (kt < 4 || k2 == 64) { const float y = C[j] + Dd[j]; OT[k2 * OTB_LD + 16 * w + r] = (bf16_t)(cvt_pk_bf16(y, y) & 0xffffu); }
                    if (kt < 4 && k2 != 0) { const float y = C[j] - Dd[j]; OT[(128 - k2) * OTB_LD + 16 * w + r] = (bf16_t)(cvt_pk_bf16(y, y) & 0xffffu); } }
            }
            __syncthreads();
            bf16_t* dst = A2 + (size_t)(tb + k1) * 1024 + g * 128;
#pragma unroll
            for (int i = 0; i < 4; ++i) { const int c = threadIdx.x + i * NTHR, k2 = c >> 4, ch = c & 15;
                const u32x4 vv = *(const LAS u32x4*)((const LAS unsigned char*)OT + k2 * (OTB_LD * 2) + ch * 16);
                *(u32x4*)(dst + (size_t)k2 * 128 * 1024 + ch * 8) = vv; }
        }
#undef PB_LOAD
    }
    for (int it0 = blockIdx.x; it0 < 4096; it0 += 4 * G) {
        half8 ar[4], ai[4];
#pragma unroll
        for (int u = 0; u < 4; ++u) { const int j = it0 + u * G; if (j < 4096) { const int b = j >> 9, g = (j >> 7) & 3, k1 = j & 127, tb = TP + (b << 11);
            const _Float16* p = T2 + (size_t)tb * 1024 + (size_t)(g * 128 + k1) * 16 * 256 + 32 * (w >> 1) + 8 * q + r * 256;
            ar[u] = *(const half8*)p; ai[u] = *(const half8*)(p + 128); } }
        __syncthreads();
#pragma unroll
        for (int u = 0; u < 4; ++u) { const int j = it0 + u * G; if (j < 4096) {
            const f32x4 Dr = MFMA_H(ar[u], Sel, zero), Di = MFMA_H(ai[u], Sel, zero);
            const half8 Bf = pack_acc(Dr, Di);
            const f32x4 Y = MFMA_H(A16, Bf, zero);
#pragma unroll
            for (int jj = 0; jj < 4; ++jj) { const int k2 = 4 * q + jj; OT[(u * 16 + k2) * OTB_LD + 16 * w + r] = (bf16_t)(cvt_pk_bf16(Y[jj], Y[jj]) & 0xffffu); } } }
        __syncthreads();
#pragma unroll
        for (int i = 0; i < 2; ++i) { const int c = threadIdx.x + i * NTHR, row = c >> 4, ch = c & 15, u = row >> 4, k2 = row & 15; const int j = it0 + u * G;
            if (j < 4096) { const int b = j >> 9, g = (j >> 7) & 3, k1 = j & 127, tb = TP + (b << 11);
                const u32x4 vv = *(const LAS u32x4*)((const LAS unsigned char*)OT + row * (OTB_LD * 2) + ch * 16);
                *(u32x4*)(A2 + (size_t)(tb + k1 + 128 * k2) * 1024 + g * 128 + ch * 8) = vv; } }
    }
}

#define XB_TMO      128
#define XB_XCNT(j)  (256  + 64 * (j))
#define XB_XSUB(j)  (1280 + 64 * (j))
#define XB_XGEN(j)  (2304 + 64 * (j))
#define XB_TOP      3328
#define XB_TOPGEN   3392
#define XCD_BAR_WORDS 3456
#define XB_SPIN_CAP (1u << 18)
__device__ __forceinline__ unsigned xb_ld(unsigned* p)              { return __hip_atomic_load(p, __ATOMIC_RELAXED, __HIP_MEMORY_SCOPE_AGENT); }
__device__ __forceinline__ unsigned xb_add(unsigned* p, unsigned v) { return __hip_atomic_fetch_add(p, v, __ATOMIC_RELAXED, __HIP_MEMORY_SCOPE_AGENT); }
__device__ __forceinline__ unsigned xb_xcc_id() { return (unsigned)__builtin_amdgcn_s_getreg((3 << 11) | 20) & 0xFu; }
#define XB_SPIN(cond, bar) do { unsigned _sp = 0; while (cond) { __builtin_amdgcn_s_sleep(1); \
    if ((++_sp & 255u) == 0u) { if (xb_ld(&(bar)[XB_TMO])) break; if (_sp > XB_SPIN_CAP) { atomicAdd(&(bar)[XB_TMO], 1u); break; } } } } while (0)
struct XcdBarrier { unsigned* bar; unsigned x; volatile LAS unsigned* st; };
__device__ __forceinline__ XcdBarrier xcd_barrier_post(unsigned* bar, volatile LAS unsigned* st) {
    XcdBarrier b; b.bar = bar; b.x = xb_xcc_id(); b.st = st;
    if (threadIdx.x == 0) (void)xb_add(&bar[XB_XCNT(b.x)], 1u);
    return b;
}
__device__ __forceinline__ void xcd_barrier_complete(unsigned* bar, unsigned x, unsigned& nloc, unsigned& nx) {
    const unsigned G = gridDim.x * gridDim.y * gridDim.z;
    unsigned sum, cnt, mine, sp = 0u;
    for (;;) {
        sum = 0u; cnt = 0u; mine = 0u;
#pragma unroll
        for (unsigned j = 0; j < 16; ++j) { const unsigned c = xb_ld(&bar[XB_XCNT(j)]); sum += c; cnt += (c > 0u) ? 1u : 0u; mine = (j == x) ? c : mine; }
        if (sum == G) break;
        __builtin_amdgcn_s_sleep(1);
        if ((++sp & 255u) == 0u) { if (xb_ld(&bar[XB_TMO])) break; if (sp > XB_SPIN_CAP) { atomicAdd(&bar[XB_TMO], 1u); break; } }
    }
    nloc = mine > 0u ? mine : 1u; nx = cnt > 0u ? cnt : 1u;
}
__device__ __forceinline__ void xcd_barrier(const XcdBarrier& b) {
    asm volatile("s_waitcnt vmcnt(0)" ::: "memory");
    __syncthreads();
    if (threadIdx.x == 0) {
        unsigned* bar = b.bar;
        __builtin_amdgcn_s_waitcnt(0);
        unsigned nloc = b.st[0], nx = b.st[1];
        if (nloc == 0u) { xcd_barrier_complete(bar, b.x, nloc, nx); b.st[0] = nloc; b.st[1] = nx; }
        const unsigned old = xb_add(&bar[XB_XSUB(b.x)], 1u);
        const unsigned gen = old / nloc;
        if (old + 1u == (gen + 1u) * nloc) {
            __builtin_amdgcn_fence(__ATOMIC_RELEASE, "agent");
            asm volatile("s_waitcnt vmcnt(0)" ::: "memory");
            const unsigned og = xb_add(&bar[XB_TOP], 1u);
            const unsigned tg = og / nx;
            if (og + 1u == (tg + 1u) * nx) xb_add(&bar[XB_TOPGEN], 1u);
            else XB_SPIN(xb_ld(&bar[XB_TOPGEN]) == tg, bar);
            __builtin_amdgcn_fence(__ATOMIC_ACQUIRE, "agent");
            xb_add(&bar[XB_XGEN(b.x)], 1u);
            asm volatile("s_waitcnt vmcnt(0)" ::: "memory");
        } else {
            XB_SPIN(xb_ld(&bar[XB_XGEN(b.x)]) == gen, bar);
            __builtin_amdgcn_fence(__ATOMIC_ACQUIRE, "agent");
            asm volatile("s_waitcnt vmcnt(0)" ::: "memory");
        }
    }
    __syncthreads();
}

__global__ void __launch_bounds__(NTHR, 2) fwd_megakernel(Args a) {
    extern __shared__ __attribute__((aligned(16))) unsigned char lds_raw[];
    LAS unsigned char* lds = (LAS unsigned char*)lds_raw;
    const int G = gridDim.x;
    unsigned char* ws = a.ws;
    volatile LAS unsigned* bst = (volatile LAS unsigned*)(lds + LDS_BYTES - 64);
    if (threadIdx.x == 0) { bst[0] = 0u; bst[1] = 0u; }
    __syncthreads();
    const XcdBarrier xbar = xcd_barrier_post((unsigned*)(ws + WS_BAR), bst);

    phase_prep(a, lds, G);
    xcd_barrier(xbar);
    phase_norm1<4>(a, G);
    xcd_barrier(xbar);
    {
        pg8::Gemm g{(const bf16_t*)(ws + WS_H), (const bf16_t*)(ws + WS_W1T), T, 3072, 1024, 1024, 1024, 0, 0}; pg8::StaticOrder S; S.init(T, 3072, G, (int)blockIdx.x);
        pg8::EpiG1 E{(_Float16*)(ws + WS_UF), (bf16_t*)(ws + WS_UP), (bf16_t*)(ws + WS_GATES)};
        pg8::gemm_phase(lds, g, S, E);
    }
    xcd_barrier(xbar);
    fft_load_tables(a, lds);
    fft_pass_a(a, lds, G);
    phase_pool(a, G);
    xcd_barrier(xbar);
    fft_pass_b(a, lds, G);
    xcd_barrier(xbar);
    {
        pg8::TwoPartOrder S; S.init(T, 1024, G, (int)blockIdx.x);
        pg8::Gemm g{(const bf16_t*)(ws + WS_A2), (const bf16_t*)(ws + WS_W2T), T, 1024, 512, 1024, 1024, 1024, 1024};
        pg8::EpiMix2 E{(bf16_t*)(ws + WS_H), (const bf16_t*)(ws + WS_GATES)};
        pg8::gemm_phase(lds, g, S, E);
    }
    xcd_barrier(xbar);
    {
        pg8::Gemm g{(const bf16_t*)(ws + WS_H), (const bf16_t*)(ws + WS_W3T), T, 1024, 1024, 1024, 1024, 0, 0}; pg8::StaticOrder S; S.init(T, 1024, G, (int)blockIdx.x);
        pg8::EpiRowSS E{(bf16_t*)(ws + WS_MBUF), (float*)(ws + WS_SS1)};
        pg8::gemm_phase(lds, g, S, E);
    }
    xcd_barrier(xbar);
    phase_mid<2>(a, G);
    xcd_barrier(xbar);
    {
        pg8::Gemm g{(const bf16_t*)(ws + WS_H), (const bf16_t*)(ws + WS_W4T), T, 2 * FF, 1024, 1024, 1024, 0, 0}; pg8::StaticOrder S; S.init(T, 2 * FF, G, (int)blockIdx.x);
        pg8::EpiSwiGLU E{(bf16_t*)(ws + WS_SBUF)};
        pg8::gemm_phase(lds, g, S, E);
    }
    xcd_barrier(xbar);
    if (G == 256) {
        pg8::Gemm g{(const bf16_t*)(ws + WS_SBUF), (const bf16_t*)(ws + WS_W5T), T, 1024, FF, FF, FF, 0, 0}; pg8::StaticOrder S; S.init(T, 1024, G, (int)blockIdx.x);
        pg8::EpiFinal E{a.out, (const bf16_t*)(ws + WS_X1B), (const float*)(ws + WS_ADA), a.in[18], (float*)(ws + WS_SSX), (unsigned*)(ws + WS_XCTR), (LAS float*)(lds + 131072)};
        pg8::gemm_phase(lds, g, S, E);
    } else {
        {
            pg8::Gemm g{(const bf16_t*)(ws + WS_SBUF), (const bf16_t*)(ws + WS_W5T), T, 1024, FF, FF, FF, 0, 0}; pg8::StaticOrder S; S.init(T, 1024, G, (int)blockIdx.x);
            pg8::EpiRowSS E{(bf16_t*)(ws + WS_ZBUF), (float*)(ws + WS_SS2)};
            pg8::gemm_phase(lds, g, S, E);
        }
        xcd_barrier(xbar);
        phase_final<4>(a, G);
    }
}

extern "C" void kernel_launch(void* const* d_in, const int* in_sizes, int n_in, void* d_out, int out_size, void* d_ws, size_t ws_size, hipStream_t stream) {
    static int grid = 0;
    if (grid == 0) {
        if (n_in != 19 || out_size != T * D || ws_size < WS_END) { fprintf(stderr, "kernel_launch: unexpected shapes (n_in %d, out %d, ws %zu)\n", n_in, out_size, ws_size); grid = -1; return; }
        int dev = 0, cus = 0, per_cu = 0;
        if (hipGetDevice(&dev) != hipSuccess || hipDeviceGetAttribute(&cus, hipDeviceAttributeMultiprocessorCount, dev) != hipSuccess) { grid = -1; return; }
        if (hipFuncSetAttribute((const void*)fwd_megakernel, hipFuncAttributeMaxDynamicSharedMemorySize, LDS_BYTES) != hipSuccess) { fprintf(stderr, "kernel_launch: hipFuncSetAttribute failed\n"); grid = -1; return; }
        if (hipOccupancyMaxActiveBlocksPerMultiprocessor(&per_cu, (const void*)fwd_megakernel, NTHR, LDS_BYTES) != hipSuccess || per_cu < 1) { fprintf(stderr, "kernel_launch: occupancy query failed (%d)\n", per_cu); (void)hipGetLastError(); grid = -1; return; }
        grid = cus * per_cu;
    }
    if (grid < 0) return;
    if (hipMemsetAsync((char*)d_ws + WS_BAR, 0, WS_MEMSET_BYTES, stream) != hipSuccess) { fprintf(stderr, "kernel_launch: memset failed\n"); return; }
    Args a{};
    for (int i = 0; i < 19; ++i) a.in[i] = (const float*)d_in[i];
    a.out = (float*)d_out; a.ws = (unsigned char*)d_ws;
    void* args[] = {&a};
    hipError_t e = hipLaunchCooperativeKernel((const void*)fwd_megakernel, dim3(grid), dim3(NTHR), args, LDS_BYTES, stream);
    if (e != hipSuccess) fprintf(stderr, "kernel_launch: cooperative launch failed: %s (grid %d)\n", hipGetErrorString(e), grid);
}
```
